# Optimizing an MI355X kernel written in HIP

```python
import math
import jax, jax.numpy as jnp
from jax import lax
import numpy as np

D_MODEL = 1024
BATCH = 32
SEQ = 2048
DEPTH = 1

MIX_WIDTH = D_MODEL
SSM_WIDTH = MIX_WIDTH // 2
ATTN_WIDTH = MIX_WIDTH - SSM_WIDTH
SSM_GROUP = 16
SSM_GROUPS = SSM_WIDTH // SSM_GROUP
SSM_STATE = 64
HEAD_DIM = 64
N_HEADS = ATTN_WIDTH // HEAD_DIM
IDX_HEADS = 8
IDX_DIM = 64
TOPK_MAX = 256
QBLOCK = 32
NUM_BUCKETS = 32
MAX_DISTANCE = 128
EPS = 1e-6
DT_MIN = 1e-3
DT_MAX = 1e-1
SPLITS = (SSM_WIDTH, SSM_WIDTH, ATTN_WIDTH, ATTN_WIDTH, ATTN_WIDTH, ATTN_WIDTH,
          IDX_HEADS * IDX_DIM, IDX_DIM, IDX_HEADS)
IN_WIDTH = 2 * SSM_WIDTH + 4 * ATTN_WIDTH + IDX_HEADS * IDX_DIM + IDX_DIM + IDX_HEADS

kernel_name = "hybrid_s5_dsa_parallel_heads"


def rms_norm(x, g):
    xf = x.astype(jnp.float32)
    xf = xf * lax.rsqrt(jnp.mean(xf * xf, axis=-1, keepdims=True) + EPS)
    return (xf * g.astype(jnp.float32)).astype(x.dtype)


def t5_causal_bucket(dist):
    max_exact = NUM_BUCKETS // 2
    is_small = dist < max_exact
    d = jnp.maximum(dist, 1).astype(jnp.float32)
    large = max_exact + (jnp.log(d / max_exact) / math.log(MAX_DISTANCE / max_exact)
                         * (NUM_BUCKETS - max_exact)).astype(jnp.int32)
    large = jnp.minimum(large, NUM_BUCKETS - 1)
    return jnp.where(is_small, dist, large)


def _ssm_combine(e1, e2):
    a1, b1 = e1
    a2, b2 = e2
    return a1 * a2, a2 * b1 + b2


def s5_mixer(u, a_re, a_im, log_dt, b_re, b_im, c_re, c_im, d_skip, w_glu, b_glu):
    bsz, seq, _ = u.shape
    uf = u.astype(jnp.float32)
    ug = uf.reshape(bsz, seq, SSM_GROUPS, SSM_GROUP)
    lam = lax.complex(a_re.astype(jnp.float32), a_im.astype(jnp.float32))
    dt = jnp.exp(log_dt.astype(jnp.float32))[:, None]
    lam_bar = jnp.exp(lam * dt)
    b_mat = lax.complex(b_re.astype(jnp.float32), b_im.astype(jnp.float32))
    b_bar = ((lam_bar - 1.0) / lam)[..., None] * b_mat
    bu = jnp.einsum('gpc,bsgc->bsgp', b_bar, ug.astype(jnp.complex64))
    a_seq = jnp.broadcast_to(lam_bar, (1, seq) + lam_bar.shape)
    _, states = lax.associative_scan(_ssm_combine, (a_seq, bu), axis=1)
    c_mat = lax.complex(c_re.astype(jnp.float32), c_im.astype(jnp.float32))
    y = jnp.einsum('gcp,bsgp->bsgc', c_mat, states).real.reshape(bsz, seq, SSM_WIDTH)
    y = y + d_skip.astype(jnp.float32) * uf
    z = jax.nn.gelu(y)
    z = z * jax.nn.sigmoid(z @ w_glu.astype(jnp.float32) + b_glu.astype(jnp.float32))
    return z.astype(u.dtype)


def dsa_mixer(q, k, v, q_idx, k_idx, w_idx, q_gain, k_gain, rel_bias):
    bsz, seq = q.shape[0], q.shape[1]
    topk = min(TOPK_MAX, seq // 4)
    nb = seq // QBLOCK
    scale = HEAD_DIM ** -0.5
    q = rms_norm(q.reshape(bsz, seq, N_HEADS, HEAD_DIM), q_gain)
    k = rms_norm(k.reshape(bsz, seq, N_HEADS, HEAD_DIM), k_gain)
    v = v.reshape(bsz, seq, N_HEADS, HEAD_DIM)
    q_idx = q_idx.reshape(bsz, seq, IDX_HEADS, IDX_DIM)
    w_idx = w_idx * (IDX_HEADS ** -0.5)
    key_pos = jnp.arange(seq, dtype=jnp.int32)

    def to_blocks(t):
        return jnp.moveaxis(t.reshape((bsz, nb, QBLOCK) + t.shape[2:]), 1, 0)

    gather = jax.vmap(lambda src, idx: src[idx])

    def block(args):
        qb, qib, wib, pos = args
        rel = jnp.einsum('bqhd,bsd->bqhs', qib, k_idx)
        score = jnp.einsum('bqh,bqhs->bqs', wib, jax.nn.relu(rel)).astype(jnp.float32)
        causal = key_pos[None, :] <= pos[:, None]
        score = jnp.where(causal[None], score, -jnp.inf)
        _, sel = lax.top_k(score, topk)
        k_sel = gather(k, sel)
        v_sel = gather(v, sel)
        logits = jnp.einsum('bqhd,bqkhd->bqhk', qb, k_sel).astype(jnp.float32) * scale
        dist = pos[None, :, None] - sel
        bias = rel_bias[t5_causal_bucket(jnp.maximum(dist, 0))]
        logits = logits + jnp.transpose(bias, (0, 1, 3, 2)).astype(jnp.float32)
        logits = jnp.where((dist >= 0)[:, :, None, :], logits, -jnp.inf)
        p = jax.nn.softmax(logits, axis=-1).astype(v.dtype)
        return jnp.einsum('bqhk,bqkhd->bqhd', p, v_sel)

    out = lax.map(block, (to_blocks(q), to_blocks(q_idx), to_blocks(w_idx),
                          key_pos.reshape(nb, QBLOCK)))
    return jnp.moveaxis(out, 0, 1).reshape(bsz, seq, ATTN_WIDTH)


def setup_inputs(seed: int = 0) -> dict:
    key = jax.random.key(seed)
    ks = jax.random.split(key, 24)
    f32 = jnp.float32
    x = jax.random.normal(ks[0], (BATCH, SEQ, D_MODEL), f32)
    c = jax.random.normal(ks[1], (BATCH, D_MODEL), f32)
    rel_bias = 0.5 * jax.random.normal(ks[2], (NUM_BUCKETS, N_HEADS), f32)
    norm_g = 1.0 + 0.05 * jax.random.normal(ks[3], (DEPTH, D_MODEL), f32)
    w_ada = 0.5 * D_MODEL ** -0.5 * jax.random.normal(ks[4], (DEPTH, D_MODEL, 3 * D_MODEL), f32)
    b_ada = 0.01 * jax.random.normal(ks[5], (DEPTH, 3 * D_MODEL), f32)
    w_in = D_MODEL ** -0.5 * jax.random.normal(ks[6], (DEPTH, D_MODEL, IN_WIDTH), f32)
    q_gain = 1.0 + 0.05 * jax.random.normal(ks[7], (DEPTH, HEAD_DIM), f32)
    k_gain = 1.0 + 0.05 * jax.random.normal(ks[8], (DEPTH, HEAD_DIM), f32)
    n = jnp.arange(SSM_STATE, dtype=f32)
    a_re = -0.5 + 0.01 * jax.random.normal(ks[9], (DEPTH, SSM_GROUPS, SSM_STATE), f32)
    a_im = math.pi * n + 0.01 * jax.random.normal(ks[10], (DEPTH, SSM_GROUPS, SSM_STATE), f32)
    log_dt = jax.random.uniform(ks[11], (DEPTH, SSM_GROUPS), f32,
                                minval=math.log(DT_MIN), maxval=math.log(DT_MAX))
    b_re = (2 * SSM_GROUP) ** -0.5 * jax.random.normal(ks[12], (DEPTH, SSM_GROUPS, SSM_STATE, SSM_GROUP), f32)
    b_im = (2 * SSM_GROUP) ** -0.5 * jax.random.normal(ks[13], (DEPTH, SSM_GROUPS, SSM_STATE, SSM_GROUP), f32)
    c_re = (2 * SSM_STATE) ** -0.5 * jax.random.normal(ks[14], (DEPTH, SSM_GROUPS, SSM_GROUP, SSM_STATE), f32)
    c_im = (2 * SSM_STATE) ** -0.5 * jax.random.normal(ks[15], (DEPTH, SSM_GROUPS, SSM_GROUP, SSM_STATE), f32)
    d_skip = jax.random.normal(ks[16], (DEPTH, SSM_WIDTH), f32)
    w_glu = SSM_WIDTH ** -0.5 * jax.random.normal(ks[17], (DEPTH, SSM_WIDTH, SSM_WIDTH), f32)
    b_glu = 0.01 * jax.random.normal(ks[18], (DEPTH, SSM_WIDTH), f32)
    w_out = MIX_WIDTH ** -0.5 * jax.random.normal(ks[19], (DEPTH, MIX_WIDTH, D_MODEL), f32)
    return {"x": x, "c": c, "rel_bias": rel_bias, "norm_g": norm_g, "w_ada": w_ada,
            "b_ada": b_ada, "w_in": w_in, "q_gain": q_gain, "k_gain": k_gain,
            "a_re": a_re, "a_im": a_im, "log_dt": log_dt, "b_re": b_re, "b_im": b_im,
            "c_re": c_re, "c_im": c_im, "d_skip": d_skip, "w_glu": w_glu, "b_glu": b_glu,
            "w_out": w_out}


def reference(x, c, rel_bias, norm_g, w_ada, b_ada, w_in, q_gain, k_gain, a_re, a_im,
              log_dt, b_re, b_im, c_re, c_im, d_skip, w_glu, b_glu, w_out):
    split_points = np.cumsum(SPLITS)[:-1].tolist()
    cond = jax.nn.silu(c)
    for l in range(DEPTH):
        mod = cond @ w_ada[l] + b_ada[l]
        shift, scale, gate = jnp.split(mod, 3, axis=-1)
        h = rms_norm(x, norm_g[l]) * (1.0 + scale[:, None, :]) + shift[:, None, :]
        proj = h @ w_in[l]
        ssm_u, ssm_z, q, k, v, attn_z, q_idx, k_idx, w_idx = jnp.split(proj, split_points, axis=-1)
        y_ssm = s5_mixer(ssm_u, a_re[l], a_im[l], log_dt[l], b_re[l], b_im[l], c_re[l], c_im[l],
                         d_skip[l], w_glu[l], b_glu[l]) * jax.nn.silu(ssm_z)
        y_attn = dsa_mixer(q, k, v, q_idx, k_idx, w_idx, q_gain[l], k_gain[l], rel_bias) * jax.nn.silu(attn_z)
        y = jnp.concatenate([y_ssm, y_attn], axis=-1) @ w_out[l]
        x = x + gate[:, None, :] * y
    return x
```

```cpp
#include <hip/hip_runtime.h>
#include <hip/hip_cooperative_groups.h>
#include <cstdio>
#include <cstdint>
#include <cmath>
namespace pg8 {
#define PG8_LAS __attribute__((address_space(3)))
typedef unsigned short bf16_t;
typedef _Float16 bf16x8 __attribute__((ext_vector_type(8)));
typedef float f32x4 __attribute__((ext_vector_type(4)));
typedef unsigned u32x4 __attribute__((ext_vector_type(4)));
constexpr int BM = 256, BK = 64, HALF = 128, HTB = HALF * BK * 2  , STAGE_BYTES = 8 * HTB, NXCD = 8, WGM = 8;

__host__ __device__ __forceinline__ int lds_byte(int r, int c) { const int st = (r >> 4) * 2 + (c >> 5), rr = r & 15, cc = c & 31, ob = rr * 64 + cc * 2; return st * 1024 + (ob ^ (((ob >> 9) & 1) << 5)); }
__host__ __device__ __forceinline__ void stage_rc(int b, int& R, int& C) { const int st = b / 1024, sb = b % 1024, swz = sb ^ (((sb >> 9) & 1) << 5); R = (st >> 1) * 16 + swz / 64; C = (st & 1) * 32 + (swz % 64) / 2; }
__host__ __device__ __forceinline__ int perm32(int rho) { const int n = rho >> 4, i = rho & 15; return 8 * (i >> 2) + 4 * n + (i & 3); }

struct Unit { int pm, pn; };
struct Gemm { const bf16_t* A; const bf16_t* Bt; int M, N, K; };

struct StaticOrder {
    int nM, nN, nwg, G, c;
    __host__ __device__ void init(int M, int N, int G_, int c_) { nM = M / BM; nN = N / BM; nwg = nM * nN; G = G_; c = c_; }
    __host__ __device__ bool next(int i, Unit& u) const {
        const long L = (long)i * G + c; if (L >= nwg) return false;
        int wgid = (int)L; { const int q = nwg / NXCD, r = nwg % NXCD, xcd = wgid % NXCD, off = wgid / NXCD; wgid = (xcd < r ? xcd * (q + 1) : r * (q + 1) + (xcd - r) * q) + off; }
        const int nig = WGM * nN, gid = wgid / nig, fm = gid * WGM, gsz = (nM - fm) < WGM ? (nM - fm) : WGM;
        u.pm = fm + ((wgid % nig) % gsz); u.pn = (wgid % nig) / gsz; return true;
    }
    __device__ __forceinline__ void a_ready(const Unit&) const {}
    __device__ __forceinline__ void done(const Unit&) const {}
};

template <class Epi, class Sched, bool ALIGN_EPI = false, bool SP2 = false>
__device__ __forceinline__ void gemm_phase(PG8_LAS unsigned char* lds, const Gemm g, const Sched& S, const Epi& E) {
    const int tid = threadIdx.x, wid = __builtin_amdgcn_readfirstlane(tid >> 6), lane = tid & 63, wr = wid >> 2, wc = wid & 3, fr = lane & 15, fq = lane >> 4;
    const int K = g.K, nt = K / BK;
    unsigned voffA[2], voffB[2];
#pragma unroll
    for (int i = 0; i < 2; ++i) { int R, C; stage_rc(tid * 16 + i * 8192, R, C); const int Rb = Epi::PERM ? ((R & ~31) + perm32(R & 31)) : R;
        voffA[i] = (unsigned)(R * K + C) * 2u; voffB[i] = (unsigned)(Rb * K + C) * 2u; }
    const size_t kstep = (size_t)(BK * 2);
    const size_t hstep = (size_t)HALF * K * 2;
    const size_t tstep = 2 * hstep;
    const unsigned ldsw = (unsigned)wid * 1024u;
    const int aoff = lds_byte(wr * 64 + fr, fq * 8), boff = lds_byte(wc * 32 + fr, fq * 8);
#define PG8_SA(b, h) (((b) * 2 + (h)) * HTB)
#define PG8_SB(b, h) ((4 + (b) * 2 + (h)) * HTB)
#define PG8_STAGE(bufoff, gbase, voff) do { _Pragma("unroll") for (int _i = 0; _i < 2; ++_i) \
        __builtin_amdgcn_global_load_lds((const unsigned*)((const char*)(gbase) + (voff)[_i]), (PG8_LAS unsigned*)(lds + (bufoff) + ldsw + _i * 8192), 16, 0, 0); } while (0)
#define PG8_LDA(dst, b, h) do { _Pragma("unroll") for (int m = 0; m < 4; ++m) _Pragma("unroll") for (int k = 0; k < 2; ++k) dst[m][k] = *(const PG8_LAS bf16x8*)(lds + PG8_SA(b, h) + aoff + m * 2048 + k * 1024); } while (0)
#define PG8_LDB(dst, b, h) do { _Pragma("unroll") for (int n = 0; n < 2; ++n) _Pragma("unroll") for (int k = 0; k < 2; ++k) dst[n][k] = *(const PG8_LAS bf16x8*)(lds + PG8_SB(b, h) + boff + n * 2048 + k * 1024); } while (0)
#define PG8_MMA(ai, bj, At, Bt) do { __builtin_amdgcn_s_setprio(1); _Pragma("unroll") for (int m = 0; m < 4; ++m) _Pragma("unroll") for (int n = 0; n < 2; ++n) _Pragma("unroll") for (int k = 0; k < 2; ++k) \
        acc[ai][bj][m][n] = __builtin_amdgcn_mfma_f32_16x16x32_f16(Bt[n][k], At[m][k], acc[ai][bj][m][n], 0, 0, 0); __builtin_amdgcn_s_setprio(0); } while (0)
#define PG8_WAIT_V(n) asm volatile("s_waitcnt vmcnt(" #n ")" ::: "memory")
#define PG8_WAIT_L(n) asm volatile("s_waitcnt lgkmcnt(" #n ")" ::: "memory")
#define PG8_BAR __builtin_amdgcn_s_barrier()
#define PG8_SCHED __builtin_amdgcn_sched_barrier(0)
    Unit cur, nxt; int ui = 0;
    if (!S.next(0, cur)) return;
    f32x4 acc[2][2][4][2];
#pragma unroll
    for (int a = 0; a < 2; ++a)
#pragma unroll
        for (int b = 0; b < 2; ++b)
#pragma unroll
            for (int m = 0; m < 4; ++m)
#pragma unroll
                for (int n = 0; n < 2; ++n) acc[a][b][m][n] = (f32x4){0.f, 0.f, 0.f, 0.f};
    bf16x8 At[4][2], B0[2][2], B1[2][2];
    const char* cA = (const char*)g.A + (size_t)cur.pm * tstep; const char* cB = (const char*)g.Bt + (size_t)cur.pn * tstep;
    S.a_ready(cur);
    if constexpr (SP2) {
        PG8_STAGE(PG8_SB(0, 0), cB, voffB); PG8_STAGE(PG8_SB(0, 1), cB + hstep, voffB); PG8_STAGE(PG8_SA(0, 0), cA, voffA); PG8_STAGE(PG8_SA(0, 1), cA + hstep, voffA);
        if (wr == 1) PG8_BAR;
        PG8_WAIT_V(2); PG8_BAR;
        PG8_STAGE(PG8_SB(1, 0), cB + kstep, voffB); PG8_STAGE(PG8_SA(1, 0), cA + kstep, voffA); PG8_STAGE(PG8_SB(1, 1), cB + hstep + kstep, voffB);
        PG8_WAIT_V(6); PG8_BAR;
    } else {
        PG8_STAGE(PG8_SB(0, 0), cB, voffB); PG8_STAGE(PG8_SA(0, 0), cA, voffA); PG8_STAGE(PG8_SB(0, 1), cB + hstep, voffB); PG8_STAGE(PG8_SA(0, 1), cA + hstep, voffA);
        if (wr == 1) PG8_BAR;
        PG8_WAIT_V(4); PG8_BAR;
        PG8_STAGE(PG8_SB(1, 0), cB + kstep, voffB); PG8_STAGE(PG8_SA(1, 0), cA + kstep, voffA); PG8_STAGE(PG8_SB(1, 1), cB + hstep + kstep, voffB);
        PG8_WAIT_V(6); PG8_BAR;
    }
    for (;;) {
        const bool has_next = S.next(ui + 1, nxt);
        const char* nA = has_next ? (const char*)g.A + (size_t)nxt.pm * tstep : cA; const char* nB = has_next ? (const char*)g.Bt + (size_t)nxt.pn * tstep : cB;
        for (int t = 0; t < nt; t += 2) {
            const bool last = (t == nt - 2);
            const char* a1 = cA + (size_t)(t + 1) * kstep;
            const char* a2 = last ? nA : cA + (size_t)(t + 2) * kstep; const char* b2 = last ? nB : cB + (size_t)(t + 2) * kstep;
            const char* a3 = a2 + kstep; const char* b3 = b2 + kstep;
            if (last && has_next) S.a_ready(nxt);
            if constexpr (SP2) {
            PG8_LDB(B0, 0, 0); PG8_LDB(B1, 0, 1); PG8_SCHED; PG8_LDA(At, 0, 0); PG8_STAGE(PG8_SA(1, 1), a1 + hstep, voffA);
            PG8_WAIT_V(8); PG8_WAIT_L(0); PG8_BAR; PG8_MMA(0, 0, At, B0); PG8_MMA(0, 1, At, B1); PG8_BAR; PG8_SCHED;
            PG8_LDA(At, 0, 1); PG8_STAGE(PG8_SB(0, 0), b2, voffB); PG8_STAGE(PG8_SB(0, 1), b2 + hstep, voffB); PG8_STAGE(PG8_SA(0, 0), a2, voffA);
            PG8_WAIT_V(8); PG8_WAIT_L(0); PG8_BAR; PG8_MMA(1, 0, At, B0); PG8_MMA(1, 1, At, B1); PG8_BAR; PG8_SCHED;
            PG8_LDB(B0, 1, 0); PG8_LDB(B1, 1, 1); PG8_SCHED; PG8_LDA(At, 1, 0); PG8_STAGE(PG8_SA(0, 1), a2 + hstep, voffA);
            PG8_WAIT_V(8); PG8_WAIT_L(0); PG8_BAR; PG8_MMA(0, 0, At, B0); PG8_MMA(0, 1, At, B1); PG8_BAR; PG8_SCHED;
            PG8_LDA(At, 1, 1); PG8_STAGE(PG8_SB(1, 0), b3, voffB); PG8_STAGE(PG8_SB(1, 1), b3 + hstep, voffB); PG8_STAGE(PG8_SA(1, 0), a3, voffA);
            PG8_WAIT_V(8); PG8_WAIT_L(0); PG8_BAR; PG8_MMA(1, 0, At, B0); PG8_MMA(1, 1, At, B1); PG8_BAR; PG8_SCHED;
            } else {
            PG8_LDB(B0, 0, 0); PG8_SCHED; PG8_LDA(At, 0, 0); PG8_STAGE(PG8_SA(1, 1), a1 + hstep, voffA);
            PG8_WAIT_L(8); PG8_BAR; PG8_WAIT_L(0); PG8_MMA(0, 0, At, B0); PG8_BAR; PG8_SCHED;
            PG8_LDB(B1, 0, 1); PG8_STAGE(PG8_SB(0, 0), b2, voffB);
            PG8_BAR; PG8_WAIT_L(0); PG8_MMA(0, 1, At, B1); PG8_BAR;
            PG8_LDA(At, 0, 1); PG8_STAGE(PG8_SA(0, 0), a2, voffA);
            PG8_BAR; PG8_WAIT_L(0); PG8_MMA(1, 0, At, B0); PG8_BAR; PG8_SCHED;
            PG8_STAGE(PG8_SB(0, 1), b2 + hstep, voffB);
            PG8_WAIT_V(6); PG8_BAR; PG8_MMA(1, 1, At, B1); PG8_BAR;
            PG8_LDB(B0, 1, 0); PG8_SCHED; PG8_LDA(At, 1, 0); PG8_STAGE(PG8_SA(0, 1), a2 + hstep, voffA);
            PG8_WAIT_L(8); PG8_BAR; PG8_WAIT_L(0); PG8_MMA(0, 0, At, B0); PG8_BAR; PG8_SCHED;
            PG8_LDB(B1, 1, 1); PG8_STAGE(PG8_SB(1, 0), b3, voffB);
            PG8_BAR; PG8_WAIT_L(0); PG8_MMA(0, 1, At, B1); PG8_BAR;
            PG8_LDA(At, 1, 1); PG8_STAGE(PG8_SA(1, 0), a3, voffA);
            PG8_BAR; PG8_WAIT_L(0); PG8_MMA(1, 0, At, B0); PG8_BAR; PG8_SCHED;
            PG8_STAGE(PG8_SB(1, 1), b3 + hstep, voffB);
            PG8_WAIT_V(6); PG8_BAR; PG8_MMA(1, 1, At, B1); PG8_BAR;
            }
        }
        if constexpr (ALIGN_EPI) { if (wr == 0) PG8_BAR; }
        if constexpr (!Epi::AFTER_DRAIN) { E(acc, cur, wr, wc, fr, fq); S.done(cur); }
        if (!has_next) break;
#pragma unroll
        for (int a = 0; a < 2; ++a)
#pragma unroll
            for (int b = 0; b < 2; ++b)
#pragma unroll
                for (int m = 0; m < 4; ++m)
#pragma unroll
                    for (int n = 0; n < 2; ++n) acc[a][b][m][n] = (f32x4){0.f, 0.f, 0.f, 0.f};
        cur = nxt; cA = nA; cB = nB; ++ui;
        if constexpr (ALIGN_EPI) { if (wr == 1) PG8_BAR; }
    }
    PG8_WAIT_V(0);
    if constexpr (!ALIGN_EPI) { if (wr == 0) PG8_BAR; }
    PG8_BAR;
    if constexpr (Epi::AFTER_DRAIN) { E.fused(acc, cur, wr, wc, fr, fq, lds, wid, lane); S.done(cur); }
#undef PG8_SA
#undef PG8_SB
#undef PG8_STAGE
#undef PG8_LDA
#undef PG8_LDB
#undef PG8_MMA
#undef PG8_WAIT_V
#undef PG8_WAIT_L
#undef PG8_BAR
#undef PG8_SCHED
}
}
#define LAS __attribute__((address_space(3)))
typedef unsigned short u16;
typedef _Float16 h16;
typedef _Float16 h16x8 __attribute__((ext_vector_type(8)));
typedef _Float16 h16x4 __attribute__((ext_vector_type(4)));
typedef _Float16 h16x2 __attribute__((ext_vector_type(2)));
typedef float f32x2 __attribute__((ext_vector_type(2)));
typedef float f32x4 __attribute__((ext_vector_type(4)));
typedef unsigned u32x4 __attribute__((ext_vector_type(4)));
typedef unsigned u32x2 __attribute__((ext_vector_type(2)));

constexpr int NB = 32, SEQ = 2048, DM = 1024, MT = NB * SEQ, NIN = 3656, NPAD = 3840;
constexpr float RMS_EPS = 1e-6f, LOG2E = 1.4426950408889634f, QSCALE = 0.125f * 1.4426950408889634f;
constexpr size_t MiB = 1u << 20;
constexpr size_t WS_MOD = 1 * MiB, WS_WIN = 2 * MiB, WS_WOUT = 10 * MiB, WS_WGLU = 12 * MiB, WS_LB = 13 * MiB, WS_BB = 14 * MiB;
constexpr size_t WS_H = 32 * MiB, WS_U = 160 * MiB, WS_ZS = 224 * MiB, WS_Q = 288 * MiB, WS_K = 352 * MiB, WS_V = 416 * MiB, WS_ZA = 480 * MiB;
constexpr size_t WS_QI = 544 * MiB, WS_KI = 608 * MiB, WS_WI = 616 * MiB, WS_ZG = 620 * MiB, WS_MASK = 684 * MiB, WS_END = 700 * MiB;
constexpr int LDS_BYTES = 147456;

struct Params {
    const float *x, *c, *rel_bias, *norm_g, *w_ada, *b_ada, *w_in, *q_gain, *k_gain, *a_re, *a_im, *log_dt, *b_re, *b_im, *c_re, *c_im, *d_skip, *w_glu, *b_glu, *w_out;
    float* out;
    float* mod;
    u16 *win_t, *wout_t, *wglu_t;
    f32x2 *LB, *BB;
    u16 *H;
    u16 *U, *ZS, *Q, *K, *V, *ZA, *QI, *KI, *ZG;
    float* WI;
    unsigned* mask;
};

__device__ __forceinline__ unsigned pkh(float a, float b) { f32x2 v = {a, b}; h16x2 h = __builtin_convertvector(v, h16x2); return __builtin_bit_cast(unsigned, h); }
__device__ __forceinline__ u32x4 pack8(const f32x4 a, const f32x4 b) { u32x4 w; w.x = pkh(a[0], a[1]); w.y = pkh(a[2], a[3]); w.z = pkh(b[0], b[1]); w.w = pkh(b[2], b[3]); return w; }
__device__ __forceinline__ float silu_f(float v) { return v / (1.f + __expf(-v)); }
__device__ __forceinline__ float sigmoid_f(float v) { return 1.f / (1.f + __expf(-v)); }
__device__ __forceinline__ float gelu_tanh_f(float v) { const float t = tanhf(0.7978845608028654f * (v + 0.044715f * v * v * v)); return 0.5f * v * (1.f + t); }
__device__ __forceinline__ int t5_bucket(int d) {
    if (d < 16) return d;
    int b = 16;
    b += (d >= 19); b += (d >= 21); b += (d >= 24); b += (d >= 27); b += (d >= 31); b += (d >= 35); b += (d >= 40); b += (d >= 46);
    b += (d >= 52); b += (d >= 59); b += (d >= 67); b += (d >= 77); b += (d >= 87); b += (d >= 99); b += (d >= 113);
    return b;
}
__device__ __forceinline__ int wave_sum_i(int v) {
#pragma unroll
    for (int o = 1; o < 64; o <<= 1) v += __shfl_xor(v, o);
    return v;
}
__device__ __forceinline__ float wave_sum_f(float v) {
#pragma unroll
    for (int o = 1; o < 64; o <<= 1) v += __shfl_xor(v, o);
    return v;
}
#define LDS_WAIT() asm volatile("s_waitcnt lgkmcnt(0)" ::: "memory")

struct EpiProj {
    static constexpr bool PERM = true, AFTER_DRAIN = false;
    Params P;
    __device__ __forceinline__ void operator()(const f32x4 (&acc)[2][2][4][2], const pg8::Unit& u, int wr, int wc, int fr, int fq) const {
        const int pn = u.pn, kind = pn >> 1;
        const int row0 = u.pm * 256 + wr * 64 + fr;
        const int lc = (pn & 1) * 256 + 64 * wc + 8 * fq;
        if (pn == 14) {
            if (wc == 0) {
#pragma unroll
                for (int ai = 0; ai < 2; ++ai)
#pragma unroll
                    for (int m = 0; m < 4; ++m) { const size_t row = (size_t)(row0 + ai * 128 + m * 16);
#pragma unroll
                        for (int bj = 0; bj < 2; ++bj) *(u32x4*)(P.KI + row * 64 + 32 * bj + 8 * fq) = pack8(acc[ai][bj][m][0], acc[ai][bj][m][1]); }
            } else if (wc == 1 && fq == 0) {
#pragma unroll
                for (int ai = 0; ai < 2; ++ai)
#pragma unroll
                    for (int m = 0; m < 4; ++m) { const size_t row = (size_t)(row0 + ai * 128 + m * 16);
                        *(f32x4*)(P.WI + row * 8) = acc[ai][0][m][0]; *(f32x4*)(P.WI + row * 8 + 4) = acc[ai][0][m][1]; }
            }
            return;
        }
        if (kind == 2 || kind == 3) {
            const float* gp = (kind == 2 ? P.q_gain : P.k_gain) + 8 * fq;
            const float sc = (kind == 2) ? QSCALE : 1.f;
            f32x4 gv[2][2];
#pragma unroll
            for (int bj = 0; bj < 2; ++bj)
#pragma unroll
                for (int n = 0; n < 2; ++n) gv[bj][n] = *(const f32x4*)(gp + 32 * bj + 4 * n) * sc;
            u16* O = (kind == 2 ? P.Q : P.K);
#pragma unroll
            for (int ai = 0; ai < 2; ++ai)
#pragma unroll
                for (int m = 0; m < 4; ++m) { const size_t row = (size_t)(row0 + ai * 128 + m * 16);
                    float ss = 0.f;
#pragma unroll
                    for (int bj = 0; bj < 2; ++bj)
#pragma unroll
                        for (int n = 0; n < 2; ++n) { const f32x4 v = acc[ai][bj][m][n]; ss += (v[0] * v[0] + v[1] * v[1]) + (v[2] * v[2] + v[3] * v[3]); }
                    ss += __shfl_xor(ss, 16); ss += __shfl_xor(ss, 32);
                    const float rs = 1.0f / sqrtf(ss * (1.0f / 64.0f) + RMS_EPS);
#pragma unroll
                    for (int bj = 0; bj < 2; ++bj) *(u32x4*)(O + row * 512 + lc + 32 * bj) = pack8(acc[ai][bj][m][0] * rs * gv[bj][0], acc[ai][bj][m][1] * rs * gv[bj][1]); }
            return;
        }
        u16* O = kind == 0 ? P.U : kind == 1 ? P.ZS : kind == 4 ? P.V : kind == 5 ? P.ZA : P.QI;
        const bool act = (kind == 1 || kind == 5);
#pragma unroll
        for (int ai = 0; ai < 2; ++ai)
#pragma unroll
            for (int m = 0; m < 4; ++m) { const size_t row = (size_t)(row0 + ai * 128 + m * 16);
#pragma unroll
                for (int bj = 0; bj < 2; ++bj) { f32x4 v0 = acc[ai][bj][m][0], v1 = acc[ai][bj][m][1];
                    if (act) {
#pragma unroll
                        for (int e = 0; e < 4; ++e) { v0[e] = silu_f(v0[e]); v1[e] = silu_f(v1[e]); } }
                    *(u32x4*)(O + row * 512 + lc + 32 * bj) = pack8(v0, v1); } }
    }
};
struct EpiGlu {
    static constexpr bool PERM = true, AFTER_DRAIN = false;
    Params P;
    __device__ __forceinline__ void operator()(const f32x4 (&acc)[2][2][4][2], const pg8::Unit& u, int wr, int wc, int fr, int fq) const {
        const int row0 = u.pm * 256 + wr * 64 + fr, col0 = u.pn * 256 + wc * 32 + 8 * fq;
        f32x4 bv[2][2];
#pragma unroll
        for (int bj = 0; bj < 2; ++bj)
#pragma unroll
            for (int n = 0; n < 2; ++n) bv[bj][n] = *(const f32x4*)(P.b_glu + col0 + bj * 128 + 4 * n);
#pragma unroll
        for (int ai = 0; ai < 2; ++ai)
#pragma unroll
            for (int m = 0; m < 4; ++m) { const size_t row = (size_t)(row0 + ai * 128 + m * 16);
#pragma unroll
                for (int bj = 0; bj < 2; ++bj) { const int col = col0 + bj * 128;
                    const h16x8 z = *(const h16x8*)(P.ZG + row * 512 + col), zs = *(const h16x8*)(P.ZS + row * 512 + col);
                    f32x4 v0 = acc[ai][bj][m][0] + bv[bj][0], v1 = acc[ai][bj][m][1] + bv[bj][1];
#pragma unroll
                    for (int e = 0; e < 4; ++e) { v0[e] = (float)z[e] * sigmoid_f(v0[e]) * (float)zs[e]; v1[e] = (float)z[4 + e] * sigmoid_f(v1[e]) * (float)zs[4 + e]; }
                    *(u32x4*)(P.H + row * 1024 + col) = pack8(v0, v1); } }
    }
};
struct EpiOut {
    static constexpr bool PERM = false, AFTER_DRAIN = false;
    Params P;
    __device__ __forceinline__ void operator()(const f32x4 (&acc)[2][2][4][2], const pg8::Unit& u, int wr, int wc, int fr, int fq) const {
        const int row0 = u.pm * 256 + wr * 64 + fr, col0 = u.pn * 256 + wc * 32 + 4 * fq;
        const float* gate = P.mod + (size_t)(u.pm >> 3) * 3072 + 2048;
        f32x4 gv[2][2];
#pragma unroll
        for (int bj = 0; bj < 2; ++bj)
#pragma unroll
            for (int n = 0; n < 2; ++n) gv[bj][n] = *(const f32x4*)(gate + col0 + bj * 128 + n * 16);
#pragma unroll
        for (int ai = 0; ai < 2; ++ai)
#pragma unroll
            for (int m = 0; m < 4; ++m) { const size_t off = (size_t)(row0 + ai * 128 + m * 16) * 1024 + col0;
#pragma unroll
                for (int bj = 0; bj < 2; ++bj)
#pragma unroll
                    for (int n = 0; n < 2; ++n) { const f32x4 xv = *(const f32x4*)(P.x + off + bj * 128 + n * 16);
                        *(f32x4*)(P.out + off + bj * 128 + n * 16) = xv + gv[bj][n] * acc[ai][bj][m][n]; } }
    }
};
__device__ __forceinline__ void p0_mod_unit(const Params& P, LAS unsigned char* lds, int unit) {
    const int tid = threadIdx.x, wave = tid >> 6, lane = tid & 63;
    LAS float* cond = (LAS float*)lds;
    for (int i = tid; i < 32 * 1024; i += 512) { const int b = i & 31, k = i >> 5; const float cv = P.c[b * 1024 + k]; cond[i] = cv / (1.f + expf(-cv)); }
    __syncthreads();
    float acc[32];
#pragma unroll
    for (int b = 0; b < 32; ++b) acc[b] = 0.f;
    const float* w = P.w_ada + (size_t)(wave * 128) * 3072 + unit * 64 + lane;
#pragma unroll 4
    for (int k = 0; k < 128; ++k) {
        const float wv = w[(size_t)k * 3072];
        const LAS f32x4* cp = (const LAS f32x4*)(cond + (wave * 128 + k) * 32);
#pragma unroll
        for (int j = 0; j < 8; ++j) { const f32x4 c4 = cp[j]; acc[4 * j] += c4[0] * wv; acc[4 * j + 1] += c4[1] * wv; acc[4 * j + 2] += c4[2] * wv; acc[4 * j + 3] += c4[3] * wv; }
    }
    __syncthreads();
    LAS float* part = (LAS float*)lds;
#pragma unroll
    for (int b = 0; b < 32; ++b) part[(wave * 32 + b) * 64 + lane] = acc[b];
    __syncthreads();
    for (int o = tid; o < 2048; o += 512) { const int b = o >> 6, cl = o & 63; float s = P.b_ada[unit * 64 + cl];
#pragma unroll
        for (int wv = 0; wv < 8; ++wv) s += part[(wv * 32 + b) * 64 + cl];
        P.mod[b * 3072 + unit * 64 + cl] = s; }
    __syncthreads();
}
__device__ __forceinline__ void transpose_item(const float* W, int K, int N, u16* WT, int n0, int prow0, int k0, LAS float* scr, int lane) {
    const int n = n0 + (lane & 31); const bool ok = n < N;
#pragma unroll 8
    for (int i = 0; i < 32; ++i) { const int kk = 2 * i + (lane >> 5); scr[kk * 33 + (lane & 31)] = ok ? W[(size_t)(k0 + kk) * N + n] : 0.f; }
    LDS_WAIT();
    const int c = lane & 7;
#pragma unroll
    for (int j = 0; j < 4; ++j) { const int nn = (lane >> 3) + 8 * j; const LAS float* s = scr + (8 * c) * 33 + nn;
        u32x4 o; o.x = pkh(s[0], s[33]); o.y = pkh(s[2 * 33], s[3 * 33]); o.z = pkh(s[4 * 33], s[5 * 33]); o.w = pkh(s[6 * 33], s[7 * 33]);
        *(u32x4*)(WT + (size_t)(prow0 + nn) * K + k0 + 8 * c) = o; }
    LDS_WAIT();
}
__device__ __forceinline__ void p0_prologue(const Params& P, LAS unsigned char* lds) {
    const int tid = threadIdx.x, wave = tid >> 6, lane = tid & 63, G = gridDim.x;
    for (int unit = blockIdx.x; unit < 48; unit += G) p0_mod_unit(P, lds, unit);
    LAS float* scr = (LAS float*)(lds + wave * 8448);
    const int gw = blockIdx.x * 8 + wave, NGW = G * 8;
    constexpr int I_IN = 16 * 120, I_OUT = 16 * 32, I_GLU = 8 * 16;
    for (int it = gw; it < I_IN + I_OUT + I_GLU; it += NGW) {
        int r = it;
        if (r < I_IN) { const int kb = r / 120, nb = r % 120, pn = nb >> 3, bj = (nb >> 2) & 1, wc = nb & 3;
            transpose_item(P.w_in, 1024, NIN, P.win_t, 256 * pn + 64 * wc + 32 * bj, 32 * nb, 64 * kb, scr, lane); continue; }
        r -= I_IN;
        if (r < I_OUT) { const int kb = r / 32, nb = r % 32; transpose_item(P.w_out, 1024, 1024, P.wout_t, 32 * nb, 32 * nb, 64 * kb, scr, lane); continue; }
        r -= I_OUT;
        { const int kb = r / 16, nb = r % 16; transpose_item(P.w_glu, 512, 512, P.wglu_t, 32 * nb, 32 * nb, 64 * kb, scr, lane); }
    }
    for (int i = blockIdx.x * 512 + tid; i < 2048; i += G * 512) {
        const int g = i >> 6;
        const double dt = exp((double)P.log_dt[g]), ar = P.a_re[i], ai = P.a_im[i];
        const double e = exp(ar * dt); double sn, cs; sincos(ai * dt, &sn, &cs);
        const double lr = e * cs, li = e * sn;
        const double nr = lr - 1.0, ni = li, den = ar * ar + ai * ai;
        const double cr = (nr * ar + ni * ai) / den, ci = (ni * ar - nr * ai) / den;
        P.LB[i] = (f32x2){(float)lr, (float)li};
        for (int c = 0; c < 16; ++c) { const double br = P.b_re[i * 16 + c], bi = P.b_im[i * 16 + c]; P.BB[i * 16 + c] = (f32x2){(float)(cr * br - ci * bi), (float)(cr * bi + ci * br)}; }
    }
}
__device__ __forceinline__ void p1_norm(const Params& P) {
    const int tid = threadIdx.x, wave = tid >> 6, lane = tid & 63;
    const int gw = blockIdx.x * 8 + wave, NGW = gridDim.x * 8;
    for (int row = gw; row < MT; row += NGW) {
        const f32x4* xr = (const f32x4*)(P.x + (size_t)row * 1024) + lane;
        f32x4 v[4]; float ss = 0.f;
#pragma unroll
        for (int j = 0; j < 4; ++j) { v[j] = xr[64 * j]; ss += (v[j][0] * v[j][0] + v[j][1] * v[j][1]) + (v[j][2] * v[j][2] + v[j][3] * v[j][3]); }
        ss = wave_sum_f(ss);
        const float rs = 1.0f / sqrtf(ss * (1.0f / 1024.0f) + RMS_EPS);
        const float* md = P.mod + (size_t)(row >> 11) * 3072;
        u32x2* o = (u32x2*)(P.H + (size_t)row * 1024) + lane;
#pragma unroll
        for (int j = 0; j < 4; ++j) { const f32x4 g = ((const f32x4*)P.norm_g)[lane + 64 * j], sh = ((const f32x4*)md)[lane + 64 * j], sc = ((const f32x4*)(md + 1024))[lane + 64 * j];
            const f32x4 h = (v[j] * rs * g) * (sc + 1.0f) + sh;
            u32x2 w; w.x = pkh(h[0], h[1]); w.y = pkh(h[2], h[3]); o[64 * j] = w; }
    }
}
__device__ __forceinline__ void ssm_simple_pair(const Params& P, LAS unsigned char* lds, int pair) {
    const int tid = threadIdx.x, wave = tid >> 6, lane = tid & 63;
    const int b = pair >> 5, g = pair & 31;
    LAS float* xs = (LAS float*)(lds + wave * 16896);
    LAS float* cs = xs + 2 * 16 * 65;
    for (int i = lane; i < 1024; i += 64) { cs[i] = P.c_re[g * 1024 + i]; cs[1024 + i] = P.c_im[g * 1024 + i]; }
    float bre[16], bim[16];
#pragma unroll
    for (int c = 0; c < 16; ++c) { const f32x2 t = P.BB[(size_t)(g * 64 + lane) * 16 + c]; bre[c] = t[0]; bim[c] = t[1]; }
    const f32x2 lb = P.LB[g * 64 + lane];
    float xr = 0.f, xi = 0.f;
    const int t4 = lane >> 2, c4 = (lane & 3) * 4;
    float dsk[4];
#pragma unroll
    for (int e = 0; e < 4; ++e) dsk[e] = P.d_skip[16 * g + c4 + e];
    LDS_WAIT();
    for (int t0 = 0; t0 < SEQ; t0 += 16) {
        for (int tt = 0; tt < 16; ++tt) {
            const u16* up = P.U + (size_t)(b * SEQ + t0 + tt) * 512 + 16 * g;
            const h16x8 u0 = *(const h16x8*)up, u1 = *(const h16x8*)(up + 8);
            float br = 0.f, bi = 0.f;
#pragma unroll
            for (int c = 0; c < 8; ++c) { br += bre[c] * (float)u0[c]; bi += bim[c] * (float)u0[c]; br += bre[8 + c] * (float)u1[c]; bi += bim[8 + c] * (float)u1[c]; }
            const float nr = lb[0] * xr - lb[1] * xi + br, ni = lb[0] * xi + lb[1] * xr + bi; xr = nr; xi = ni;
            xs[tt * 65 + lane] = xr; xs[1040 + tt * 65 + lane] = xi;
        }
        LDS_WAIT();
        float y[4] = {0.f, 0.f, 0.f, 0.f};
        for (int p = 0; p < 64; ++p) { const float ar = xs[t4 * 65 + p], ai = xs[1040 + t4 * 65 + p];
#pragma unroll
            for (int e = 0; e < 4; ++e) y[e] += cs[(c4 + e) * 64 + p] * ar - cs[1024 + (c4 + e) * 64 + p] * ai; }
        const size_t off = (size_t)(b * SEQ + t0 + t4) * 512 + 16 * g + c4;
        const h16x4 u4 = *(const h16x4*)(P.U + off);
        u32x2 w; w.x = pkh(gelu_tanh_f(y[0] + dsk[0] * (float)u4[0]), gelu_tanh_f(y[1] + dsk[1] * (float)u4[1])); w.y = pkh(gelu_tanh_f(y[2] + dsk[2] * (float)u4[2]), gelu_tanh_f(y[3] + dsk[3] * (float)u4[3]));
        *(u32x2*)(P.ZG + off) = w;
        LDS_WAIT();
    }
}
constexpr int SC_STRIDE = 2052;
__device__ __forceinline__ void idx_unit(const Params& P, LAS unsigned char* lds, int unit) {
    const int tid = threadIdx.x, lane = tid & 63, wave = __builtin_amdgcn_readfirstlane(tid >> 6);
    const int b = unit >> 7, qb = unit & 127, q0 = qb * 16;
    unsigned* MW = P.mask + (size_t)(b * SEQ + q0) * 64;
    if (q0 + 15 <= 255) {
        for (int i = tid; i < 16 * 64; i += 512) { const int ql = i >> 6, w = i & 63, q = q0 + ql, lo = 32 * w;
            MW[i] = (q >= lo + 31) ? 0xFFFFFFFFu : (q < lo ? 0u : ((2u << (q - lo)) - 1u)); }
        return;
    }
    LAS float* SC = (LAS float*)lds;
    const int ql = lane & 15, g4 = lane >> 4;
    const size_t qrow = (size_t)(b * SEQ + q0 + ql);
    h16x8 bq[8][2];
#pragma unroll
    for (int h = 0; h < 8; ++h)
#pragma unroll
        for (int ks = 0; ks < 2; ++ks) bq[h][ks] = *(const h16x8*)(P.QI + qrow * 512 + 64 * h + 32 * ks + 8 * g4);
    float wq[8];
#pragma unroll
    for (int h = 0; h < 8; ++h) wq[h] = P.WI[qrow * 8 + h] * 0.35355339059327373f;
    const int ntile = qb + 1;
    for (int kt = wave; kt < ntile; kt += 8) {
        const int key0 = kt * 16;
        const u16* kp = P.KI + (size_t)(b * SEQ + key0 + ql) * 64 + 8 * g4;
        const h16x8 a0 = *(const h16x8*)kp, a1 = *(const h16x8*)(kp + 32);
        f32x4 sc = {0.f, 0.f, 0.f, 0.f};
#pragma unroll
        for (int h = 0; h < 8; ++h) { f32x4 r = __builtin_amdgcn_mfma_f32_16x16x32_f16(a0, bq[h][0], (f32x4){0.f, 0.f, 0.f, 0.f}, 0, 0, 0);
            r = __builtin_amdgcn_mfma_f32_16x16x32_f16(a1, bq[h][1], r, 0, 0, 0);
#pragma unroll
            for (int j = 0; j < 4; ++j) sc[j] = fmaf(wq[h], fmaxf(r[j], 0.f), sc[j]); }
        *(LAS f32x4*)(SC + ql * SC_STRIDE + key0 + 4 * g4) = sc;
    }
    __syncthreads();
    for (int qq = 0; qq < 2; ++qq) {
        const int qloc = wave * 2 + qq, q = q0 + qloc;
        unsigned u[32];
#pragma unroll
        for (int j = 0; j < 8; ++j) { const f32x4 v = *(const LAS f32x4*)(SC + qloc * SC_STRIDE + 256 * j + 4 * lane);
#pragma unroll
            for (int e = 0; e < 4; ++e) { const float f = v[e] + 0.0f; const unsigned bits = __builtin_bit_cast(unsigned, f);
                const unsigned k = (bits & 0x80000000u) ? ~bits : (bits | 0x80000000u);
                u[4 * j + e] = (256 * j + 4 * lane + e <= q) ? k : 0u; } }
        unsigned T = 0u;
#pragma unroll 1
        for (int bit = 31; bit >= 0; --bit) {
            const unsigned cand = T | (1u << bit); int c = 0;
#pragma unroll
            for (int r = 0; r < 32; ++r) c += (u[r] >= cand) ? 1 : 0;
            c = wave_sum_i(c);
            if (c >= 256) T = cand;
        }
        int cgt = 0, ceq = 0;
#pragma unroll
        for (int r = 0; r < 32; ++r) { cgt += (u[r] > T) ? 1 : 0; ceq += (u[r] == T) ? 1 : 0; }
        cgt = wave_sum_i(cgt); ceq = wave_sum_i(ceq);
        const int need = 256 - cgt;
        int idxcut = 4095;
        if (ceq > need) {
            int lo = 0, hi = 2047;
            while (lo < hi) { const int mid = (lo + hi) >> 1; int c = 0;
#pragma unroll
                for (int r = 0; r < 32; ++r) c += (u[r] == T && (256 * (r >> 2) + 4 * lane + (r & 3)) <= mid) ? 1 : 0;
                c = wave_sum_i(c);
                if (c >= need) hi = mid; else lo = mid + 1; }
            idxcut = lo;
        }
#pragma unroll
        for (int j = 0; j < 8; ++j) { unsigned nib = 0u;
#pragma unroll
            for (int e = 0; e < 4; ++e) { const unsigned uu = u[4 * j + e]; const bool s = (uu > T) || (uu == T && (256 * j + 4 * lane + e) <= idxcut); nib |= (s ? 1u : 0u) << e; }
            unsigned v = nib << (4 * (lane & 7));
            v |= __shfl_xor(v, 1); v |= __shfl_xor(v, 2); v |= __shfl_xor(v, 4);
            if ((lane & 7) == 0) MW[qloc * 64 + 8 * j + (lane >> 3)] = v; }
    }
    __syncthreads();
}
__device__ __forceinline__ void attn_simple_row(const Params& P, int row) {
    const int lane = threadIdx.x & 63;
    const int b = row >> 11, q = row & 2047, h = lane >> 3;
    float qv[8];
    { const h16x8 t = *(const h16x8*)(P.Q + (size_t)row * 512 + 8 * lane);
#pragma unroll
      for (int j = 0; j < 8; ++j) qv[j] = (float)t[j]; }
    const unsigned myword = P.mask[(size_t)row * 64 + lane];
    float m = -INFINITY, l = 0.f, o[8];
#pragma unroll
    for (int j = 0; j < 8; ++j) o[j] = 0.f;
    const int nw = (q >> 5) + 1;
    for (int w = 0; w < nw; ++w) {
        unsigned word = __builtin_amdgcn_readlane(myword, w);
        while (word) {
            const int bit = __builtin_ctz(word); word &= word - 1u;
            const int key = 32 * w + bit;
            const size_t kr = (size_t)(b * SEQ + key) * 512 + 8 * lane;
            const h16x8 kv = *(const h16x8*)(P.K + kr), vv = *(const h16x8*)(P.V + kr);
            float s = 0.f;
#pragma unroll
            for (int j = 0; j < 8; ++j) s += qv[j] * (float)kv[j];
            s += __shfl_xor(s, 1); s += __shfl_xor(s, 2); s += __shfl_xor(s, 4);
            s += P.rel_bias[t5_bucket(q - key) * 8 + h] * LOG2E;
            const float mn = fmaxf(m, s), al = exp2f(m - mn), p = exp2f(s - mn);
            l = l * al + p;
#pragma unroll
            for (int j = 0; j < 8; ++j) o[j] = o[j] * al + p * (float)vv[j];
            m = mn;
        }
    }
    const float inv = 1.f / l;
    const h16x8 za = *(const h16x8*)(P.ZA + (size_t)row * 512 + 8 * lane);
    f32x4 r0, r1;
#pragma unroll
    for (int j = 0; j < 4; ++j) { r0[j] = o[j] * inv * (float)za[j]; r1[j] = o[4 + j] * inv * (float)za[4 + j]; }
    *(u32x4*)(P.H + (size_t)row * 1024 + 512 + 8 * lane) = pack8(r0, r1);
}
#define KERNEL_HEAD extern __shared__ __attribute__((aligned(16))) unsigned char lds_raw[]; LAS unsigned char* lds = (LAS unsigned char*)lds_raw;
__global__ void __launch_bounds__(512, 2) k_p0(Params P) { KERNEL_HEAD p0_prologue(P, lds); }
__global__ void __launch_bounds__(512, 2) k_p1(Params P) { p1_norm(P); }
__global__ void __launch_bounds__(512, 2) k_p2(Params P) { KERNEL_HEAD
    pg8::Gemm g{P.H, P.win_t, MT, NPAD, 1024}; pg8::StaticOrder S; S.init(MT, NPAD, gridDim.x, (int)blockIdx.x); EpiProj E{P};
    pg8::gemm_phase<EpiProj, pg8::StaticOrder, true, true>(lds, g, S, E); }
__global__ void __launch_bounds__(512, 2) k_p3a(Params P) { KERNEL_HEAD
    const int wave = threadIdx.x >> 6;
    for (int pr = blockIdx.x * 8 + wave; pr < 1024; pr += gridDim.x * 8) ssm_simple_pair(P, lds, pr); }
__global__ void __launch_bounds__(512, 2) k_p3b(Params P) { KERNEL_HEAD
    for (int u = blockIdx.x; u < 4096; u += gridDim.x) idx_unit(P, lds, u); }
__global__ void __launch_bounds__(512, 2) k_p4a(Params P) {
    const int wave = threadIdx.x >> 6;
    for (int row = blockIdx.x * 8 + wave; row < MT; row += gridDim.x * 8) attn_simple_row(P, row); }
__global__ void __launch_bounds__(512, 2) k_p4b(Params P) { KERNEL_HEAD
    pg8::Gemm g{P.ZG, P.wglu_t, MT, 512, 512}; pg8::StaticOrder S; S.init(MT, 512, gridDim.x, (int)blockIdx.x); EpiGlu E{P};
    pg8::gemm_phase<EpiGlu, pg8::StaticOrder, true, true>(lds, g, S, E); }
__global__ void __launch_bounds__(512, 2) k_p5(Params P) { KERNEL_HEAD
    pg8::Gemm g{P.H, P.wout_t, MT, 1024, 1024}; pg8::StaticOrder S; S.init(MT, 1024, gridDim.x, (int)blockIdx.x); EpiOut E{P};
    pg8::gemm_phase<EpiOut, pg8::StaticOrder, true, true>(lds, g, S, E); }

extern "C" void kernel_launch(void* const* d_in, const int* in_sizes, int n_in, void* d_out, int out_size, void* d_ws, size_t ws_size, hipStream_t stream) {
    static int ready = 0;
    if (!ready) {
        if (n_in != 20 || in_sizes[0] != MT * DM || out_size != MT * DM || ws_size < WS_END) { fprintf(stderr, "kernel_launch: unexpected shapes (n_in %d, in0 %d, out %d, ws %zu)\n", n_in, n_in > 0 ? in_sizes[0] : -1, out_size, ws_size); ready = -1; return; }
        const void* ks[] = {(const void*)k_p0, (const void*)k_p2, (const void*)k_p3a, (const void*)k_p3b, (const void*)k_p4b, (const void*)k_p5};
        for (const void* k : ks) if (hipFuncSetAttribute(k, hipFuncAttributeMaxDynamicSharedMemorySize, LDS_BYTES) != hipSuccess) { fprintf(stderr, "kernel_launch: hipFuncSetAttribute failed\n"); ready = -1; return; }
        ready = 1;
    }
    if (ready < 0) return;
    Params P{};
    const float* const* in = (const float* const*)d_in;
    P.x = in[0]; P.c = in[1]; P.rel_bias = in[2]; P.norm_g = in[3]; P.w_ada = in[4]; P.b_ada = in[5]; P.w_in = in[6]; P.q_gain = in[7]; P.k_gain = in[8]; P.a_re = in[9]; P.a_im = in[10];
    P.log_dt = in[11]; P.b_re = in[12]; P.b_im = in[13]; P.c_re = in[14]; P.c_im = in[15]; P.d_skip = in[16]; P.w_glu = in[17]; P.b_glu = in[18]; P.w_out = in[19];
    unsigned char* ws = (unsigned char*)d_ws;
    P.out = (float*)d_out; P.mod = (float*)(ws + WS_MOD); P.win_t = (u16*)(ws + WS_WIN); P.wout_t = (u16*)(ws + WS_WOUT); P.wglu_t = (u16*)(ws + WS_WGLU);
    P.LB = (f32x2*)(ws + WS_LB); P.BB = (f32x2*)(ws + WS_BB); P.H = (u16*)(ws + WS_H); P.U = (u16*)(ws + WS_U); P.ZS = (u16*)(ws + WS_ZS); P.Q = (u16*)(ws + WS_Q); P.K = (u16*)(ws + WS_K);
    P.V = (u16*)(ws + WS_V); P.ZA = (u16*)(ws + WS_ZA); P.QI = (u16*)(ws + WS_QI); P.KI = (u16*)(ws + WS_KI); P.WI = (float*)(ws + WS_WI); P.ZG = (u16*)(ws + WS_ZG); P.mask = (unsigned*)(ws + WS_MASK);
    const dim3 grid(256), blk(512);
    hipLaunchKernelGGL(k_p0, grid, blk, LDS_BYTES, stream, P);
    hipLaunchKernelGGL(k_p1, grid, blk, 0, stream, P);
    hipLaunchKernelGGL(k_p2, grid, blk, LDS_BYTES, stream, P);
    hipLaunchKernelGGL(k_p3a, grid, blk, LDS_BYTES, stream, P);
    hipLaunchKernelGGL(k_p3b, grid, blk, LDS_BYTES, stream, P);
    hipLaunchKernelGGL(k_p4a, grid, blk, 0, stream, P);
    hipLaunchKernelGGL(k_p4b, grid, blk, LDS_BYTES, stream, P);
    hipLaunchKernelGGL(k_p5, grid, blk, LDS_BYTES, stream, P);
}
```

```cpp
#include <hip/hip_runtime.h>
#include <hip/hip_cooperative_groups.h>
#include <cstdio>
#include <cstdint>
#include <cmath>
namespace pg8 {
#define PG8_LAS __attribute__((address_space(3)))
typedef unsigned short bf16_t;
typedef _Float16 bf16x8 __attribute__((ext_vector_type(8)));
typedef float f32x4 __attribute__((ext_vector_type(4)));
typedef unsigned u32x4 __attribute__((ext_vector_type(4)));
constexpr int BM = 256, BK = 64, HALF = 128, HTB = HALF * BK * 2  , STAGE_BYTES = 8 * HTB, NXCD = 8, WGM = 2;

__host__ __device__ __forceinline__ int lds_byte(int r, int c) { const int st = (r >> 4) * 2 + (c >> 5), rr = r & 15, cc = c & 31, ob = rr * 64 + cc * 2; return st * 1024 + (ob ^ (((ob >> 9) & 1) << 5)); }
__host__ __device__ __forceinline__ void stage_rc(int b, int& R, int& C) { const int st = b / 1024, sb = b % 1024, swz = sb ^ (((sb >> 9) & 1) << 5); R = (st >> 1) * 16 + swz / 64; C = (st & 1) * 32 + (swz % 64) / 2; }
__host__ __device__ __forceinline__ int perm32(int rho) { const int n = rho >> 4, i = rho & 15; return 8 * (i >> 2) + 4 * n + (i & 3); }

struct Unit { int pm, pn; };
struct Gemm { const bf16_t* A; const bf16_t* Bt; int M, N, K; };

struct StaticOrder {
    int nM, nN, nwg, G, c, wgm;
    __host__ __device__ void init(int M, int N, int G_, int c_, int wgm_ = WGM) { nM = M / BM; nN = N / BM; nwg = nM * nN; G = G_; c = c_; wgm = wgm_; }
    __host__ __device__ bool next(int i, Unit& u) const {
        const long L = (long)i * G + c; if (L >= nwg) return false;
        int wgid = (int)L; { const int q = nwg / NXCD, r = nwg % NXCD, xcd = wgid % NXCD, off = wgid / NXCD; wgid = (xcd < r ? xcd * (q + 1) : r * (q + 1) + (xcd - r) * q) + off; }
        const int nig = wgm * nN, gid = wgid / nig, fm = gid * wgm, gsz = (nM - fm) < wgm ? (nM - fm) : wgm;
        u.pm = fm + ((wgid % nig) % gsz); u.pn = (wgid % nig) / gsz; return true;
    }
    __device__ __forceinline__ void a_ready(const Unit&) const {}
    __device__ __forceinline__ void done(const Unit&) const {}
};

template <class Epi, class Sched, bool ALIGN_EPI = false, bool SP2 = false>
__device__ __forceinline__ void gemm_phase(PG8_LAS unsigned char* lds, const Gemm g, const Sched& S, const Epi& E, const int tid_in = -1) {
    const int tid = tid_in >= 0 ? tid_in : (int)threadIdx.x, wid = __builtin_amdgcn_readfirstlane(tid >> 6), lane = tid & 63, wr = wid >> 2, wc = wid & 3, fr = lane & 15, fq = lane >> 4;
    const int K = g.K, nt = K / BK;
    unsigned voffA[2], voffB[2];
#pragma unroll
    for (int i = 0; i < 2; ++i) { int R, C; stage_rc(tid * 16 + i * 8192, R, C); const int Rb = Epi::PERM ? ((R & ~31) + perm32(R & 31)) : R;
        voffA[i] = (unsigned)(R * K + C) * 2u; voffB[i] = (unsigned)(Rb * K + C) * 2u; }
    const size_t kstep = (size_t)(BK * 2);
    const size_t hstep = (size_t)HALF * K * 2;
    const size_t tstep = 2 * hstep;
    const unsigned ldsw = (unsigned)wid * 1024u;
    const int aoff = lds_byte(wr * 64 + fr, fq * 8), boff = lds_byte(wc * 32 + fr, fq * 8);
#define PG8_SA(b, h) (((b) * 2 + (h)) * HTB)
#define PG8_SB(b, h) ((4 + (b) * 2 + (h)) * HTB)
#define PG8_STAGE(bufoff, gbase, voff) do { _Pragma("unroll") for (int _i = 0; _i < 2; ++_i) \
        __builtin_amdgcn_global_load_lds((const unsigned*)((const char*)(gbase) + (voff)[_i]), (PG8_LAS unsigned*)(lds + (bufoff) + ldsw + _i * 8192), 16, 0, 0); } while (0)
#define PG8_LDA(dst, b, h) do { _Pragma("unroll") for (int m = 0; m < 4; ++m) _Pragma("unroll") for (int k = 0; k < 2; ++k) dst[m][k] = *(const PG8_LAS bf16x8*)(lds + PG8_SA(b, h) + aoff + m * 2048 + k * 1024); } while (0)
#define PG8_LDB(dst, b, h) do { _Pragma("unroll") for (int n = 0; n < 2; ++n) _Pragma("unroll") for (int k = 0; k < 2; ++k) dst[n][k] = *(const PG8_LAS bf16x8*)(lds + PG8_SB(b, h) + boff + n * 2048 + k * 1024); } while (0)
#define PG8_MMA(ai, bj, At, Bt) do { __builtin_amdgcn_s_setprio(1); _Pragma("unroll") for (int m = 0; m < 4; ++m) _Pragma("unroll") for (int n = 0; n < 2; ++n) _Pragma("unroll") for (int k = 0; k < 2; ++k) \
        acc[ai][bj][m][n] = __builtin_amdgcn_mfma_f32_16x16x32_f16(Bt[n][k], At[m][k], acc[ai][bj][m][n], 0, 0, 0); __builtin_amdgcn_s_setprio(0); } while (0)
#define PG8_WAIT_V(n) asm volatile("s_waitcnt vmcnt(" #n ")" ::: "memory")
#define PG8_WAIT_L(n) asm volatile("s_waitcnt lgkmcnt(" #n ")" ::: "memory")
#define PG8_BAR __builtin_amdgcn_s_barrier()
#define PG8_SCHED __builtin_amdgcn_sched_barrier(0)
    Unit cur, nxt; int ui = 0;
    if (!S.next(0, cur)) return;
    f32x4 acc[2][2][4][2];
#pragma unroll
    for (int a = 0; a < 2; ++a)
#pragma unroll
        for (int b = 0; b < 2; ++b)
#pragma unroll
            for (int m = 0; m < 4; ++m)
#pragma unroll
                for (int n = 0; n < 2; ++n) acc[a][b][m][n] = (f32x4){0.f, 0.f, 0.f, 0.f};
    bf16x8 At[4][2], B0[2][2], B1[2][2];
    const char* cA = (const char*)g.A + (size_t)cur.pm * tstep; const char* cB = (const char*)g.Bt + (size_t)cur.pn * tstep;
    S.a_ready(cur);
    if constexpr (SP2) {
        PG8_STAGE(PG8_SB(0, 0), cB, voffB); PG8_STAGE(PG8_SB(0, 1), cB + hstep, voffB); PG8_STAGE(PG8_SA(0, 0), cA, voffA); PG8_STAGE(PG8_SA(0, 1), cA + hstep, voffA);
        if (wr == 1) PG8_BAR;
        PG8_WAIT_V(2); PG8_BAR;
        PG8_STAGE(PG8_SB(1, 0), cB + kstep, voffB); PG8_STAGE(PG8_SA(1, 0), cA + kstep, voffA); PG8_STAGE(PG8_SB(1, 1), cB + hstep + kstep, voffB);
        PG8_WAIT_V(6); PG8_BAR;
    } else {
        PG8_STAGE(PG8_SB(0, 0), cB, voffB); PG8_STAGE(PG8_SA(0, 0), cA, voffA); PG8_STAGE(PG8_SB(0, 1), cB + hstep, voffB); PG8_STAGE(PG8_SA(0, 1), cA + hstep, voffA);
        if (wr == 1) PG8_BAR;
        PG8_WAIT_V(4); PG8_BAR;
        PG8_STAGE(PG8_SB(1, 0), cB + kstep, voffB); PG8_STAGE(PG8_SA(1, 0), cA + kstep, voffA); PG8_STAGE(PG8_SB(1, 1), cB + hstep + kstep, voffB);
        PG8_WAIT_V(6); PG8_BAR;
    }
    for (;;) {
        const bool has_next = S.next(ui + 1, nxt);
        const char* nA = has_next ? (const char*)g.A + (size_t)nxt.pm * tstep : cA; const char* nB = has_next ? (const char*)g.Bt + (size_t)nxt.pn * tstep : cB;
        for (int t = 0; t < nt; t += 2) {
            const bool last = (t == nt - 2);
            const char* a1 = cA + (size_t)(t + 1) * kstep;
            const char* a2 = last ? nA : cA + (size_t)(t + 2) * kstep; const char* b2 = last ? nB : cB + (size_t)(t + 2) * kstep;
            const char* a3 = a2 + kstep; const char* b3 = b2 + kstep;
            if (last && has_next) S.a_ready(nxt);
            if constexpr (SP2) {
            PG8_LDB(B0, 0, 0); PG8_LDB(B1, 0, 1); PG8_SCHED; PG8_LDA(At, 0, 0); PG8_STAGE(PG8_SA(1, 1), a1 + hstep, voffA);
            PG8_WAIT_V(8); PG8_WAIT_L(0); PG8_BAR; PG8_MMA(0, 0, At, B0); PG8_MMA(0, 1, At, B1); PG8_BAR; PG8_SCHED;
            PG8_LDA(At, 0, 1); PG8_STAGE(PG8_SB(0, 0), b2, voffB); PG8_STAGE(PG8_SB(0, 1), b2 + hstep, voffB); PG8_STAGE(PG8_SA(0, 0), a2, voffA);
            PG8_WAIT_V(8); PG8_WAIT_L(0); PG8_BAR; PG8_MMA(1, 0, At, B0); PG8_MMA(1, 1, At, B1); PG8_BAR; PG8_SCHED;
            PG8_LDB(B0, 1, 0); PG8_LDB(B1, 1, 1); PG8_SCHED; PG8_LDA(At, 1, 0); PG8_STAGE(PG8_SA(0, 1), a2 + hstep, voffA);
            PG8_WAIT_V(8); PG8_WAIT_L(0); PG8_BAR; PG8_MMA(0, 0, At, B0); PG8_MMA(0, 1, At, B1); PG8_BAR; PG8_SCHED;
            PG8_LDA(At, 1, 1); PG8_STAGE(PG8_SB(1, 0), b3, voffB); PG8_STAGE(PG8_SB(1, 1), b3 + hstep, voffB); PG8_STAGE(PG8_SA(1, 0), a3, voffA);
            PG8_WAIT_V(8); PG8_WAIT_L(0); PG8_BAR; PG8_MMA(1, 0, At, B0); PG8_MMA(1, 1, At, B1); PG8_BAR; PG8_SCHED;
            } else {
            PG8_LDB(B0, 0, 0); PG8_SCHED; PG8_LDA(At, 0, 0); PG8_STAGE(PG8_SA(1, 1), a1 + hstep, voffA);
            PG8_WAIT_L(8); PG8_BAR; PG8_WAIT_L(0); PG8_MMA(0, 0, At, B0); PG8_BAR; PG8_SCHED;
            PG8_LDB(B1, 0, 1); PG8_STAGE(PG8_SB(0, 0), b2, voffB);
            PG8_BAR; PG8_WAIT_L(0); PG8_MMA(0, 1, At, B1); PG8_BAR;
            PG8_LDA(At, 0, 1); PG8_STAGE(PG8_SA(0, 0), a2, voffA);
            PG8_BAR; PG8_WAIT_L(0); PG8_MMA(1, 0, At, B0); PG8_BAR; PG8_SCHED;
            PG8_STAGE(PG8_SB(0, 1), b2 + hstep, voffB);
            PG8_WAIT_V(6); PG8_BAR; PG8_MMA(1, 1, At, B1); PG8_BAR;
            PG8_LDB(B0, 1, 0); PG8_SCHED; PG8_LDA(At, 1, 0); PG8_STAGE(PG8_SA(0, 1), a2 + hstep, voffA);
            PG8_WAIT_L(8); PG8_BAR; PG8_WAIT_L(0); PG8_MMA(0, 0, At, B0); PG8_BAR; PG8_SCHED;
            PG8_LDB(B1, 1, 1); PG8_STAGE(PG8_SB(1, 0), b3, voffB);
            PG8_BAR; PG8_WAIT_L(0); PG8_MMA(0, 1, At, B1); PG8_BAR;
            PG8_LDA(At, 1, 1); PG8_STAGE(PG8_SA(1, 0), a3, voffA);
            PG8_BAR; PG8_WAIT_L(0); PG8_MMA(1, 0, At, B0); PG8_BAR; PG8_SCHED;
            PG8_STAGE(PG8_SB(1, 1), b3 + hstep, voffB);
            PG8_WAIT_V(6); PG8_BAR; PG8_MMA(1, 1, At, B1); PG8_BAR;
            }
        }
        if constexpr (ALIGN_EPI) { if (wr == 0) PG8_BAR; }
        if constexpr (!Epi::AFTER_DRAIN) { E(acc, cur, wr, wc, fr, fq); S.done(cur); }
        if (!has_next) break;
#pragma unroll
        for (int a = 0; a < 2; ++a)
#pragma unroll
            for (int b = 0; b < 2; ++b)
#pragma unroll
                for (int m = 0; m < 4; ++m)
#pragma unroll
                    for (int n = 0; n < 2; ++n) acc[a][b][m][n] = (f32x4){0.f, 0.f, 0.f, 0.f};
        cur = nxt; cA = nA; cB = nB; ++ui;
        if constexpr (ALIGN_EPI) { if (wr == 1) PG8_BAR; }
    }
    PG8_WAIT_V(0);
    if constexpr (!ALIGN_EPI) { if (wr == 0) PG8_BAR; }
    PG8_BAR;
    if constexpr (Epi::AFTER_DRAIN) { E.fused(acc, cur, wr, wc, fr, fq, lds, wid, lane); S.done(cur); }
#undef PG8_SA
#undef PG8_SB
#undef PG8_STAGE
#undef PG8_LDA
#undef PG8_LDB
#undef PG8_MMA
#undef PG8_WAIT_V
#undef PG8_WAIT_L
#undef PG8_BAR
#undef PG8_SCHED
}
}
#ifndef MK_COOP
#define MK_COOP 0
#endif
#define LAS __attribute__((address_space(3)))
typedef unsigned short u16;
typedef _Float16 h16;
typedef _Float16 h16x8 __attribute__((ext_vector_type(8)));
typedef _Float16 h16x4 __attribute__((ext_vector_type(4)));
typedef _Float16 h16x2 __attribute__((ext_vector_type(2)));
typedef float f32x2 __attribute__((ext_vector_type(2)));
typedef float f32x4 __attribute__((ext_vector_type(4)));
typedef unsigned u32x4 __attribute__((ext_vector_type(4)));
typedef unsigned u32x2 __attribute__((ext_vector_type(2)));
typedef float f32x16 __attribute__((ext_vector_type(16)));

constexpr int NB = 32, SEQ = 2048, DM = 1024, MT = NB * SEQ, NIN = 3656, NPAD = 3840;
constexpr float RMS_EPS = 1e-6f, LOG2E = 1.4426950408889634f, QSCALE = 0.125f * 1.4426950408889634f;
constexpr size_t MiB = 1u << 20;
constexpr size_t WS_MOD = 20 * MiB  , WS_WIN = 2 * MiB, WS_WOUT = 10 * MiB, WS_WGLU = 12 * MiB, WS_LB = 13 * MiB, WS_BB = 14 * MiB, WS_BBH = 15 * MiB, WS_CCH = 16 * MiB, WS_DT = 17 * MiB;
constexpr int PT = 520;
constexpr size_t WS_H = 32 * MiB, WS_U = 160 * MiB, WS_ZS = 225 * MiB, WS_Q = 290 * MiB, WS_K = 355 * MiB, WS_V = 420 * MiB, WS_ZA = 485 * MiB;
constexpr size_t WS_QI = 550 * MiB, WS_KI = 615 * MiB, WS_WI = 623 * MiB, WS_ZG = 626 * MiB, WS_MASK = 690 * MiB, WS_END = 706 * MiB;
constexpr int CTL_BAR = 1024, CTL_WORDS = 1024 + 3456;
constexpr int LDS_BYTES = 147456, LDS_MISC = 143360;

struct Params {
    const float *x, *c, *rel_bias, *norm_g, *w_ada, *b_ada, *w_in, *q_gain, *k_gain, *a_re, *a_im, *log_dt, *b_re, *b_im, *c_re, *c_im, *d_skip, *w_glu, *b_glu, *w_out;
    float* out;
    float* mod;
    u16 *win_t, *wout_t, *wglu_t;
    f32x2 *LB, *BB;
    u16 *BBh, *CCh;
    float* DT;
    unsigned* ctl;
    u16 *H;
    u16 *U, *ZS, *Q, *K, *V, *ZA, *QI, *KI, *ZG;
    float* WI;
    unsigned* mask;
};

__device__ __forceinline__ unsigned pkh(float a, float b) { f32x2 v = {a, b}; h16x2 h = __builtin_convertvector(v, h16x2); return __builtin_bit_cast(unsigned, h); }
__device__ __forceinline__ u32x4 pack8(const f32x4 a, const f32x4 b) { u32x4 w; w.x = pkh(a[0], a[1]); w.y = pkh(a[2], a[3]); w.z = pkh(b[0], b[1]); w.w = pkh(b[2], b[3]); return w; }
__device__ __forceinline__ float silu_f(float v) { return v * __builtin_amdgcn_rcpf(1.f + __builtin_amdgcn_exp2f(-1.4426950408889634f * v)); }
__device__ __forceinline__ float sigmoid_f(float v) { return __builtin_amdgcn_rcpf(1.f + __builtin_amdgcn_exp2f(-1.4426950408889634f * v)); }
__device__ __forceinline__ float gelu_tanh_f(float v) { const float t = tanhf(0.7978845608028654f * (v + 0.044715f * v * v * v)); return 0.5f * v * (1.f + t); }
__device__ __forceinline__ float gelu_fast_f(float v) { const float a = v * (1.5957691216057308f + 0.07135481627260025f * v * v); return v * __builtin_amdgcn_rcpf(1.f + __builtin_amdgcn_exp2f(-1.4426950408889634f * a)); }
__device__ __forceinline__ int wave_total_i(int v) {
    v += __builtin_amdgcn_update_dpp(0, v, 0x111, 0xF, 0xF, true); v += __builtin_amdgcn_update_dpp(0, v, 0x112, 0xF, 0xF, true);
    v += __builtin_amdgcn_update_dpp(0, v, 0x114, 0xF, 0xF, true); v += __builtin_amdgcn_update_dpp(0, v, 0x118, 0xF, 0xF, true);
    v += __builtin_amdgcn_update_dpp(0, v, 0x142, 0xA, 0xF, true); v += __builtin_amdgcn_update_dpp(0, v, 0x143, 0xC, 0xF, true);
    return __builtin_amdgcn_readlane(v, 63);
}
__device__ __forceinline__ float wave_total_f(float v) {
    v += __builtin_bit_cast(float, __builtin_amdgcn_update_dpp(0, __builtin_bit_cast(int, v), 0x111, 0xF, 0xF, true)); v += __builtin_bit_cast(float, __builtin_amdgcn_update_dpp(0, __builtin_bit_cast(int, v), 0x112, 0xF, 0xF, true));
    v += __builtin_bit_cast(float, __builtin_amdgcn_update_dpp(0, __builtin_bit_cast(int, v), 0x114, 0xF, 0xF, true)); v += __builtin_bit_cast(float, __builtin_amdgcn_update_dpp(0, __builtin_bit_cast(int, v), 0x118, 0xF, 0xF, true));
    v += __builtin_bit_cast(float, __builtin_amdgcn_update_dpp(0, __builtin_bit_cast(int, v), 0x142, 0xA, 0xF, true)); v += __builtin_bit_cast(float, __builtin_amdgcn_update_dpp(0, __builtin_bit_cast(int, v), 0x143, 0xC, 0xF, true));
    return __builtin_bit_cast(float, __builtin_amdgcn_readlane(__builtin_bit_cast(int, v), 63));
}
__device__ __forceinline__ unsigned wave_max_u(unsigned v) {
#pragma unroll
    for (int o = 1; o < 64; o <<= 1) { const unsigned t = (unsigned)__shfl_xor((int)v, o); v = t > v ? t : v; }
    return v;
}
__device__ __forceinline__ unsigned wave_min_u(unsigned v) {
#pragma unroll
    for (int o = 1; o < 64; o <<= 1) { const unsigned t = (unsigned)__shfl_xor((int)v, o); v = t < v ? t : v; }
    return v;
}
__device__ __forceinline__ unsigned f2key(float f) { const unsigned b = __builtin_bit_cast(unsigned, f); return (b & 0x80000000u) ? ~b : (b | 0x80000000u); }
__device__ __forceinline__ float key2f(unsigned k) { const unsigned b = (k & 0x80000000u) ? (k ^ 0x80000000u) : ~k; return __builtin_bit_cast(float, b); }

__device__ __forceinline__ int t5_bucket(int d) {
    if (d < 16) return d;
    int b = 16;
    b += (d >= 19); b += (d >= 21); b += (d >= 24); b += (d >= 27); b += (d >= 31); b += (d >= 35); b += (d >= 40); b += (d >= 46);
    b += (d >= 52); b += (d >= 59); b += (d >= 67); b += (d >= 77); b += (d >= 87); b += (d >= 99); b += (d >= 113);
    return b;
}
__device__ __forceinline__ int wave_sum_i(int v) {
#pragma unroll
    for (int o = 1; o < 64; o <<= 1) v += __shfl_xor(v, o);
    return v;
}
__device__ __forceinline__ float wave_sum_f(float v) {
#pragma unroll
    for (int o = 1; o < 64; o <<= 1) v += __shfl_xor(v, o);
    return v;
}
#define LDS_WAIT() asm volatile("s_waitcnt lgkmcnt(0)" ::: "memory")

struct EpiProj {
    static constexpr bool PERM = true, AFTER_DRAIN = false;
    Params P;
    __device__ __forceinline__ void operator()(const f32x4 (&acc)[2][2][4][2], const pg8::Unit& u, int wr, int wc, int fr, int fq) const {
        const int pn = u.pn, kind = pn >> 1;
        const int row0 = u.pm * 256 + wr * 64 + fr;
        const int lc = (pn & 1) * 256 + 64 * wc + 8 * fq;
        if (pn == 14) {
            if (wc == 0) {
#pragma unroll
                for (int ai = 0; ai < 2; ++ai)
#pragma unroll
                    for (int m = 0; m < 4; ++m) { const size_t row = (size_t)(row0 + ai * 128 + m * 16);
#pragma unroll
                        for (int bj = 0; bj < 2; ++bj) *(u32x4*)(P.KI + row * 64 + 32 * bj + 8 * fq) = pack8(acc[ai][bj][m][0], acc[ai][bj][m][1]); }
            } else if (wc == 1 && fq == 0) {
#pragma unroll
                for (int ai = 0; ai < 2; ++ai)
#pragma unroll
                    for (int m = 0; m < 4; ++m) { const size_t row = (size_t)(row0 + ai * 128 + m * 16);
                        *(f32x4*)(P.WI + row * 8) = acc[ai][0][m][0]; *(f32x4*)(P.WI + row * 8 + 4) = acc[ai][0][m][1]; }
            }
            return;
        }
        if (kind == 2 || kind == 3) {
            const float* gp = (kind == 2 ? P.q_gain : P.k_gain) + 8 * fq;
            const float sc = (kind == 2) ? QSCALE : 1.f;
            f32x4 gv[2][2];
#pragma unroll
            for (int bj = 0; bj < 2; ++bj)
#pragma unroll
                for (int n = 0; n < 2; ++n) gv[bj][n] = *(const f32x4*)(gp + 32 * bj + 4 * n) * sc;
            u16* O = (kind == 2 ? P.Q : P.K);
#pragma unroll
            for (int ai = 0; ai < 2; ++ai)
#pragma unroll
                for (int m = 0; m < 4; ++m) { const size_t row = (size_t)(row0 + ai * 128 + m * 16);
                    float ss = 0.f;
#pragma unroll
                    for (int bj = 0; bj < 2; ++bj)
#pragma unroll
                        for (int n = 0; n < 2; ++n) { const f32x4 v = acc[ai][bj][m][n]; ss += (v[0] * v[0] + v[1] * v[1]) + (v[2] * v[2] + v[3] * v[3]); }
                    ss += __shfl_xor(ss, 16); ss += __shfl_xor(ss, 32);
                    const float rs = __builtin_amdgcn_rsqf(ss * (1.0f / 64.0f) + RMS_EPS);
#pragma unroll
                    for (int bj = 0; bj < 2; ++bj) *(u32x4*)(O + row * PT + lc + 32 * bj) = pack8(acc[ai][bj][m][0] * rs * gv[bj][0], acc[ai][bj][m][1] * rs * gv[bj][1]); }
            return;
        }
        u16* O = kind == 0 ? P.U : kind == 1 ? P.ZS : kind == 4 ? P.V : kind == 5 ? P.ZA : P.QI;
        const bool act = (kind == 1 || kind == 5);
#pragma unroll
        for (int ai = 0; ai < 2; ++ai)
#pragma unroll
            for (int m = 0; m < 4; ++m) { const size_t row = (size_t)(row0 + ai * 128 + m * 16);
#pragma unroll
                for (int bj = 0; bj < 2; ++bj) { f32x4 v0 = acc[ai][bj][m][0], v1 = acc[ai][bj][m][1];
                    if (act) {
#pragma unroll
                        for (int e = 0; e < 4; ++e) { v0[e] = silu_f(v0[e]); v1[e] = silu_f(v1[e]); } }
                    *(u32x4*)(O + row * PT + lc + 32 * bj) = pack8(v0, v1); } }
    }
};
struct EpiGlu {
    static constexpr bool PERM = true, AFTER_DRAIN = false;
    Params P;
    __device__ __forceinline__ void operator()(const f32x4 (&acc)[2][2][4][2], const pg8::Unit& u, int wr, int wc, int fr, int fq) const {
        const int row0 = u.pm * 256 + wr * 64 + fr, col0 = u.pn * 256 + wc * 32 + 8 * fq;
        f32x4 bv[2][2];
#pragma unroll
        for (int bj = 0; bj < 2; ++bj)
#pragma unroll
            for (int n = 0; n < 2; ++n) bv[bj][n] = *(const f32x4*)(P.b_glu + col0 + bj * 128 + 4 * n);
#pragma unroll
        for (int ai = 0; ai < 2; ++ai)
#pragma unroll
            for (int m = 0; m < 4; ++m) { const size_t row = (size_t)(row0 + ai * 128 + m * 16);
#pragma unroll
                for (int bj = 0; bj < 2; ++bj) { const int col = col0 + bj * 128;
                    const h16x8 z = *(const h16x8*)(P.ZG + row * 512 + col), zs = *(const h16x8*)(P.ZS + row * PT + col);
                    f32x4 v0 = acc[ai][bj][m][0] + bv[bj][0], v1 = acc[ai][bj][m][1] + bv[bj][1];
#pragma unroll
                    for (int e = 0; e < 4; ++e) { v0[e] = (float)z[e] * sigmoid_f(v0[e]) * (float)zs[e]; v1[e] = (float)z[4 + e] * sigmoid_f(v1[e]) * (float)zs[4 + e]; }
                    *(u32x4*)(P.H + row * 1024 + col) = pack8(v0, v1); } }
    }
};
struct EpiOut {
    static constexpr bool PERM = false, AFTER_DRAIN = false;
    Params P;
    __device__ __forceinline__ void operator()(const f32x4 (&acc)[2][2][4][2], const pg8::Unit& u, int wr, int wc, int fr, int fq) const {
        const int row0 = u.pm * 256 + wr * 64 + fr, col0 = u.pn * 256 + wc * 32 + 4 * fq;
        const float* gate = P.mod + (size_t)(u.pm >> 3) * 3072 + 2048;
        f32x4 gv[2][2];
#pragma unroll
        for (int bj = 0; bj < 2; ++bj)
#pragma unroll
            for (int n = 0; n < 2; ++n) { const int cc = col0 + bj * 128 + n * 16;
                gv[bj][n] = *(const f32x4*)(P.b_ada + 2048 + cc) + ((*(const f32x4*)(gate + cc) + *(const f32x4*)(gate + 32 * 3072 + cc)) + (*(const f32x4*)(gate + 2 * 32 * 3072 + cc) + *(const f32x4*)(gate + 3 * 32 * 3072 + cc))); }
#pragma unroll
        for (int ai = 0; ai < 2; ++ai)
#pragma unroll
            for (int m = 0; m < 4; ++m) { const size_t off = (size_t)(row0 + ai * 128 + m * 16) * 1024 + col0;
#pragma unroll
                for (int bj = 0; bj < 2; ++bj)
#pragma unroll
                    for (int n = 0; n < 2; ++n) { const f32x4 xv = *(const f32x4*)(P.x + off + bj * 128 + n * 16);
                        *(f32x4*)(P.out + off + bj * 128 + n * 16) = xv + gv[bj][n] * acc[ai][bj][m][n]; } }
    }
};
namespace attn_body {
using bf16=unsigned short;
using bf16x8=__attribute__((ext_vector_type(8)))short;
using s16x4=__attribute__((ext_vector_type(4)))short;
using f32x16=__attribute__((ext_vector_type(16)))float;
using u32x4=__attribute__((ext_vector_type(4)))unsigned;
constexpr int BATCH=32,NHEAD=8,SEQ=2048,D=64,DM=520;
constexpr int NW=8,QBLK=32,QB=QBLK*NW,KVBLK=64,NQB=SEQ/QB;
constexpr int ATTN_PITCH=DM, ATTN_UNIT_ROWS=QB;
__device__ __forceinline__ int crow(int r,int hi){return (r&3)+8*(r>>2)+4*hi;}
#define SBAR() __builtin_amdgcn_sched_barrier(0)
constexpr int NSLOT=3, SLOTB=8192;
constexpr int LDS_K=0, LDS_V=NSLOT*SLOTB, LDS_WS=2*NSLOT*SLOTB, LDS_OST=LDS_WS+NW*64*4, LDS_TB=LDS_OST+NW*4096, TB_N=640, LDS_BYTES=LDS_TB+TB_N*4;
constexpr float C2=0.125f*1.4426950408889634f;
__device__ __forceinline__ void glds16s(const void*sbase,unsigned voff,unsigned lds_dst){unsigned keep;
  asm volatile("s_mov_b32 %0, m0\n\ts_mov_b32 m0, %3\n\ts_nop 2\n\tglobal_load_lds_dwordx4 %1, %2\n\ts_mov_b32 m0, %0":"=&s"(keep):"v"(voff),"s"(sbase),"s"(lds_dst):"memory");}
__device__ __forceinline__ void glds16(const void*gsrc,unsigned lds_dst){unsigned keep;
  asm volatile("s_mov_b32 %0, m0\n\ts_mov_b32 m0, %2\n\ts_nop 0\n\tglobal_load_lds_dwordx4 %1, off\n\ts_mov_b32 m0, %0":"=&s"(keep):"v"(gsrc),"s"(lds_dst):"memory");}
__device__ __forceinline__ float max3f(float a,float b,float c){float r;asm("v_max3_f32 %0, %1, %2, %3":"=v"(r):"v"(a),"v"(b),"v"(c));return r;}
__device__ __forceinline__ float max2f(float a,float b){float r;asm("v_max_f32_e32 %0, %1, %2":"=v"(r):"v"(a),"v"(b));return r;}
__device__ __forceinline__ float fadd_s(float a,float b){float r;asm("v_add_f32_e32 %0, %1, %2":"=v"(r):"v"(a),"v"(b));return r;}
__device__ __forceinline__ float fsub_s(float a,float b){float r;asm("v_sub_f32_e32 %0, %1, %2":"=v"(r):"v"(a),"v"(b));return r;}
typedef float f32x2_t __attribute__((ext_vector_type(2))); typedef _Float16 f16x2_t __attribute__((ext_vector_type(2))); typedef _Float16 f16x8_t __attribute__((ext_vector_type(8)));
#define MFMA16(a,b,c,x,y,z) __builtin_amdgcn_mfma_f32_32x32x16_f16(__builtin_bit_cast(f16x8_t,a),__builtin_bit_cast(f16x8_t,b),c,x,y,z)
__device__ __forceinline__ unsigned cvtpk_s(float lo,float hi){f32x2_t v={lo,hi};f16x2_t b=__builtin_convertvector(v,f16x2_t);return __builtin_bit_cast(unsigned,b);}
#define WAIT_BAR(N) asm volatile("s_waitcnt vmcnt(" #N ") lgkmcnt(0)\n\ts_barrier":::"memory")

__device__ __forceinline__ void qkt(f32x16&p0,f32x16&p1,const char*Kslot,const bf16x8*qr,const f32x16&negm,int r32,int hi){
  const char*kb=Kslot+hi*1024+r32*16;
  #pragma unroll
  for(int d0=0;d0<4;++d0){
    const bf16x8 b0=*reinterpret_cast<const bf16x8*>(kb+d0*2048);
    const bf16x8 b1=*reinterpret_cast<const bf16x8*>(kb+d0*2048+512);
    if(d0==0){p0=MFMA16(b0,qr[0],negm,0,0,0);p1=MFMA16(b1,qr[0],negm,0,0,0);}
    else{p0=MFMA16(b0,qr[d0],p0,0,0,0);p1=MFMA16(b1,qr[d0],p1,0,0,0);}}
}
typedef __attribute__((address_space(3))) const char* lds_cptr;
typedef short v4i16_t __attribute__((ext_vector_type(4)));
__device__ __forceinline__ void kload8(bf16x8*kf,lds_cptr kp){
  kf[0]=*(const __attribute__((address_space(3))) bf16x8*)(kp);      kf[1]=*(const __attribute__((address_space(3))) bf16x8*)(kp+512);
  kf[2]=*(const __attribute__((address_space(3))) bf16x8*)(kp+2048); kf[3]=*(const __attribute__((address_space(3))) bf16x8*)(kp+2560);
  kf[4]=*(const __attribute__((address_space(3))) bf16x8*)(kp+4096); kf[5]=*(const __attribute__((address_space(3))) bf16x8*)(kp+4608);
  kf[6]=*(const __attribute__((address_space(3))) bf16x8*)(kp+6144); kf[7]=*(const __attribute__((address_space(3))) bf16x8*)(kp+6656);
}
__device__ __forceinline__ void kload2(bf16x8*kf,lds_cptr kp,int j){ kf[2*j]=*(const __attribute__((address_space(3))) bf16x8*)(kp+j*2048); kf[2*j+1]=*(const __attribute__((address_space(3))) bf16x8*)(kp+j*2048+512); }
__device__ __forceinline__ s16x4 vtr(lds_cptr p){ return __builtin_bit_cast(s16x4,__builtin_amdgcn_ds_read_tr16_b64_v4i16((__attribute__((address_space(3))) v4i16_t*)p)); }
__device__ __forceinline__ float rowmax(const f32x16&p0,const f32x16&p1){
  float a=max3f(p0[0],p0[1],p1[0]),b=max3f(p0[2],p0[3],p1[1]);a=max3f(a,p1[2],p1[3]);
  #pragma unroll
  for(int r=4;r<16;r+=4){a=max3f(a,p0[r],p0[r+1]);b=max3f(b,p0[r+2],p0[r+3]);a=max3f(a,p1[r],p1[r+1]);b=max3f(b,p1[r+2],p1[r+3]);}
  const float m=max2f(a,b);
  auto rr=__builtin_amdgcn_permlane32_swap(__float_as_uint(m),__float_as_uint(m),false,false);
  return max2f(__uint_as_float(rr[0]),__uint_as_float(rr[1]));
}
__device__ __forceinline__ void pv(f32x16*o,int vb,bf16x8 pa0,bf16x8 pa1,bf16x8 pa2,bf16x8 pa3){
  #pragma unroll
  for(int d0=0;d0<2;++d0){s16x4 lo[4],hi[4];
    #pragma unroll
    for(int ks=0;ks<4;++ks){
      asm volatile("ds_read_b64_tr_b16 %0,%1 offset:%c2":"=&v"(lo[ks]):"v"(vb),"i"(d0*4096+ks*1024):"memory");
      asm volatile("ds_read_b64_tr_b16 %0,%1 offset:%c2":"=&v"(hi[ks]):"v"(vb),"i"(d0*4096+ks*1024+512):"memory");}
    asm volatile("s_waitcnt lgkmcnt(0)":::"memory");SBAR();
    #define PK(k) (bf16x8){lo[k][0],lo[k][1],lo[k][2],lo[k][3],hi[k][0],hi[k][1],hi[k][2],hi[k][3]}
    o[d0]=MFMA16(pa0,PK(0),o[d0],0,0,0);
    o[d0]=MFMA16(pa1,PK(1),o[d0],0,0,0);
    o[d0]=MFMA16(pa2,PK(2),o[d0],0,0,0);
    o[d0]=MFMA16(pa3,PK(3),o[d0],0,0,0);
    #undef PK
  }
}

#ifndef ATTN_STORE16
#define ATTN_STORE16(p,v) (*(u32x4*)(p)=(v))
#endif
typedef unsigned u32x2_t __attribute__((ext_vector_type(2)));
#define CINIT (f32x16{})
constexpr int OPITCH=1024;
template<int THRL,bool NOMASK=false> __device__ __forceinline__ void attn_unit(int b,int h,int qb,const bf16*Q,const bf16*__restrict__ K,const bf16*__restrict__ V,bf16*O,const bf16*__restrict__ ZA,const unsigned*__restrict__ MASK,char*shm){
  int tid_=threadIdx.x; asm volatile("":"+v"(tid_));
  const int tid=tid_,lane=tid&63,r32=lane&31,hi=lane>>5; const int wid=__builtin_amdgcn_readfirstlane(tid>>6);
  const long rowbase=(long)b*SEQ; const int q0=qb*QB;
  const bf16*Qw=Q+(rowbase+q0+wid*QBLK)*DM+h*D;
  const bf16*Kh=K+rowbase*DM+h*D,*Vh=V+rowbase*DM+h*D;
  const unsigned lds0=(unsigned)(uintptr_t)shm;
  float*wsf=(float*)(shm+LDS_WS)+wid*64;
  const bf16*ksrc=Kh+wid*8; const unsigned kvo=(unsigned)lane*(DM*2);
  const bf16*vsrc=Vh+(long)(16*(wid&3))*DM+(wid>>2)*32; const unsigned vvo=(unsigned)(lane>>2)*(DM*2)+(unsigned)(lane&3)*16;
  const unsigned kdst=lds0+LDS_K+wid*1024, vdst=lds0+LDS_V+wid*1024;
  #define DMA_K(t,slot) glds16s(ksrc+(long)(t)*KVBLK*DM,kvo,(unsigned)__builtin_amdgcn_readfirstlane(kdst+(slot)))
  #define DMA_V(t,slot) glds16s(vsrc+(long)(t)*KVBLK*DM,vvo,(unsigned)__builtin_amdgcn_readfirstlane(vdst+(slot)))
  const int vb0=(int)(lds0+LDS_V)+((lane>>4)&1)*32+(lane&3)*8+(4*hi+((lane&15)>>2))*64;
  const char*Kbase=shm+LDS_K; bf16x8 kf[8];
  const lds_cptr shm3=(lds_cptr)shm; const lds_cptr kp0=shm3+LDS_K+hi*1024+r32*16; const lds_cptr vp0=shm3+LDS_V+((lane>>4)&1)*32+(lane&3)*8+(4*hi+((lane&15)>>2))*64;
  const int NT=(q0+QB)/KVBLK;
  DMA_K(0,0);DMA_V(0,0);DMA_K(1,SLOTB);
  bf16x8 qr[4];
  #pragma unroll
  for(int d0=0;d0<4;++d0)qr[d0]=*reinterpret_cast<const bf16x8*>((const char*)Qw+((unsigned)r32*(DM*2)+(unsigned)hi*16+(unsigned)d0*32));
  float l_reg=0.f;f32x16 o[2];o[0]=f32x16{};o[1]=f32x16{};
  #define negm CINIT
  const int qabs=q0+wid*QBLK+r32; const char*mbase=(const char*)(MASK+(size_t)rowbase*64); const unsigned moff=(unsigned)qabs*256u;
  u32x2_t mwc=*(const u32x2_t*)(mbase+moff);
  #define MASKB(C0,C1,W) do{ if(NOMASK){asm volatile("":"+v"((W)));break;} const int w0_=(int)((W).x>>(4*hi)), w1_=(int)((W).y>>(4*hi)); \
    _Pragma("unroll") for(int r=0;r<16;++r){ const unsigned m0_=(unsigned)__builtin_amdgcn_sbfe(w0_,(r&3)+8*(r>>2),1), m1_=(unsigned)__builtin_amdgcn_sbfe(w1_,(r&3)+8*(r>>2),1); \
      C0[r]=__uint_as_float((__float_as_uint(C0[r])&m0_)|(0xFF800000u&~m0_)); C1[r]=__uint_as_float((__float_as_uint(C1[r])&m1_)|(0xFF800000u&~m1_)); if((r&3)==3)SBAR(); } }while(0)
  #define BIAS(C0,C1,t) do{ if((t)>=NT-6 && 64*(t)+176>q0+wid*QBLK){     int lb_=lane; asm volatile("":"+v"(lb_)); const __attribute__((address_space(3))) float* tp_=(const __attribute__((address_space(3))) float*)((lds_cptr)shm+LDS_TB)+(64*(t)+4*(lb_>>5)-(q0+wid*QBLK+(lb_&31))+383); \
    _Pragma("unroll") for(int r=0;r<16;++r){ C0[r]+=tp_[(r&3)+8*(r>>2)]; C1[r]+=tp_[32+(r&3)+8*(r>>2)]; } } }while(0)
  #define START(P0,P1) do{ \
    MASKB(P0,P1,mwc); \
    _Pragma("unroll") for(int r=0;r<16;++r)P0[r]=__builtin_amdgcn_exp2f(P0[r]); }while(0)
  #define RESC() do{}while(0)
  f32x16 pA0,pA1,pB0,pB1;
  int sl_prev=0,sl_cur=0,sl_next=SLOTB;
  #define ROT() do{sl_prev=sl_cur;sl_cur=sl_next;sl_next=(sl_next==(NSLOT-1)*SLOTB)?0:sl_next+SLOTB;}while(0)
  DMA_K(2,2*SLOTB);
  WAIT_BAR(3);
  qkt(pA0,pA1,Kbase,qr,negm,r32,hi);asm volatile("s_nop 15\n\ts_nop 7":"+v"(pA0),"+v"(pA1));BIAS(pA0,pA1,0);
  START(pA0,pA1);
  _Pragma("unroll") for(int r=0;r<16;++r)pA1[r]=__builtin_amdgcn_exp2f(pA1[r]);
  mwc=*(const u32x2_t*)(mbase+(moff+8u));
  WAIT_BAR(0);
  DMA_K(3,0);DMA_V(1,SLOTB);
  ROT();
  kload8(kf,kp0+sl_cur);
  WAIT_BAR(2);
  s16x4 vlo[8],vhi[8]; u32x4 pw0,pw1,pw2,pw3;
  #define PKW(P,B) cvtpk_s(P[B],P[B+1])
  #define PAF(k) __builtin_bit_cast(bf16x8,pw##k)
  #define VFR(i) (bf16x8){vlo[i][0],vlo[i][1],vlo[i][2],vlo[i][3],vhi[i][0],vhi[i][1],vhi[i][2],vhi[i][3]}
  #define PIN(x) asm volatile("":"+v"(x))
  #define MX3(a,b,c) __builtin_fmaxf(__builtin_fmaxf((a),(b)),(c))
  #define GAPA(MF,A0,A1,A2,A3,W0,W1,PW) do{ MF; sacc+=A0; sacc+=A1; sacc+=A2; sacc+=A3; PIN(sacc); W0; W1; PIN(PW); SBAR(); }while(0)
  #define EX(v) __builtin_amdgcn_exp2f(v)
  #define GAPB(MF,X,B) do{ MF; X[B]=EX(X[B]); X[B+1]=EX(X[B+1]); X[B+2]=EX(X[B+2]); X[B+3]=EX(X[B+3]); PIN(X); SBAR(); }while(0)
  #define VRD(i) do{ vlo[i]=vtr(vp_+(((i)>>2)*4096+((i)&3)*1024)); vhi[i]=vtr(vp_+(((i)>>2)*4096+((i)&3)*1024+512)); }while(0)
  #define KRD(G,j) do{ if(G){ kload2(kf,kp0+sl_next,j); SBAR(); } }while(0)
  #define STEP(C0,C1,P0,P1,t,GK,GV,GL) STEPM(C0,C1,P0,P1,t,GK,GV,GL,GV)
  #define STEPM(C0,C1,P0,P1,t,GK,GV,GL,GM) do{ SBAR(); \
    const lds_cptr vp_=vp0+sl_prev; \
    VRD(0); SBAR(); float sacc=(P0[0]+P0[1]); \
    GAPA(C0=MFMA16(kf[0],qr[0],negm,0,0,0), P0[2],P0[3],P0[4],P0[5],     pw0[0]=PKW(P0,0), pw0[1]=PKW(P0,2), pw0); \
    VRD(4); SBAR(); GAPA(C1=MFMA16(kf[1],qr[0],negm,0,0,0), P0[6],P0[7],P0[8],P0[9],     pw0[2]=PKW(P0,4), pw0[3]=PKW(P0,6), pw0); \
    VRD(1); SBAR(); GAPA(C0=MFMA16(kf[2],qr[1],C0,0,0,0),   P0[10],P0[11],P0[12],P0[13], pw1[0]=PKW(P0,8), pw1[1]=PKW(P0,10), pw1); \
    VRD(5); SBAR(); GAPA(C1=MFMA16(kf[3],qr[1],C1,0,0,0),   P0[14],P0[15],P1[0],P1[1],   pw1[2]=PKW(P0,12),pw1[3]=PKW(P0,14), pw1); \
    VRD(2); SBAR(); GAPA(C0=MFMA16(kf[4],qr[2],C0,0,0,0),   P1[2],P1[3],P1[4],P1[5],     pw2[0]=PKW(P1,0), pw2[1]=PKW(P1,2), pw2); \
    VRD(6); SBAR(); GAPA(C1=MFMA16(kf[5],qr[2],C1,0,0,0),   P1[6],P1[7],P1[8],P1[9],     pw2[2]=PKW(P1,4), pw2[3]=PKW(P1,6), pw2); \
    VRD(3); SBAR(); GAPA(C0=MFMA16(kf[6],qr[3],C0,0,0,0),   P1[10],P1[11],P1[12],P1[13], pw3[0]=PKW(P1,8), pw3[1]=PKW(P1,10), pw3); \
    VRD(7); SBAR(); GAPA(C1=MFMA16(kf[7],qr[3],C1,0,0,0),   P1[14],P1[15],0.f,0.f,       pw3[2]=PKW(P1,12),pw3[3]=PKW(P1,14), pw3); \
    l_reg+=sacc; \
    BIASX(C0,C1,t); \
    MASKB(C0,C1,mwc); \
    if(GM){mwc=*(const u32x2_t*)(mbase+(moff+8u*(unsigned)((t)+1)));} \
    if(GK){DMA_K((t)+3,sl_cur);} if(GV){DMA_V((t)+1,sl_next);} \
    SBAR(); \
    GAPB(o[0]=MFMA16(PAF(0),VFR(0),o[0],0,0,0), C0,0); \
    GAPB(o[1]=MFMA16(PAF(0),VFR(4),o[1],0,0,0), C0,4); \
    KRD(GL,0); GAPB(o[0]=MFMA16(PAF(1),VFR(1),o[0],0,0,0), C0,8); \
    KRD(GL,1); GAPB(o[1]=MFMA16(PAF(1),VFR(5),o[1],0,0,0), C0,12); \
    KRD(GL,2); GAPB(o[0]=MFMA16(PAF(2),VFR(2),o[0],0,0,0), C1,0); \
    KRD(GL,3); GAPB(o[1]=MFMA16(PAF(2),VFR(6),o[1],0,0,0), C1,4); \
    GAPB(o[0]=MFMA16(PAF(3),VFR(3),o[0],0,0,0), C1,8); \
    GAPB(o[1]=MFMA16(PAF(3),VFR(7),o[1],0,0,0), C1,12); \
    }while(0)
  int t=1;
  #define BIASX(P0,P1,t) do{}while(0)
  for(;t+7<NT;t+=2){
    STEP(pB0,pB1,pA0,pA1,t,true,true,true);     WAIT_BAR(2); RESC(); ROT();
    STEP(pA0,pA1,pB0,pB1,t+1,true,true,true);   WAIT_BAR(2); RESC(); ROT();
  }
  #undef BIASX
  #define BIASX(P0,P1,t) BIAS(P0,P1,t)
  #define ENDW(tt) do{ if((tt)+3<NT){WAIT_BAR(2);} else if((tt)+2<NT){WAIT_BAR(1);} else {WAIT_BAR(0);} }while(0)
  for(;t+3<NT;t+=2){
    STEP(pB0,pB1,pA0,pA1,t,true,true,true);     WAIT_BAR(2); RESC(); ROT();
    STEP(pA0,pA1,pB0,pB1,t+1,true,true,true);   WAIT_BAR(2); RESC(); ROT();
  }
  #define FIN(P0,P1,VSL) do{ float sacc=P0[0]+P0[1]; _Pragma("unroll") for(int r=2;r<16;++r)sacc+=P0[r]; _Pragma("unroll") for(int r=0;r<16;++r)sacc+=P1[r]; l_reg+=sacc; \
    pw0=(u32x4){PKW(P0,0),PKW(P0,2),PKW(P0,4),PKW(P0,6)};pw1=(u32x4){PKW(P0,8),PKW(P0,10),PKW(P0,12),PKW(P0,14)};pw2=(u32x4){PKW(P1,0),PKW(P1,2),PKW(P1,4),PKW(P1,6)};pw3=(u32x4){PKW(P1,8),PKW(P1,10),PKW(P1,12),PKW(P1,14)}; \
    SBAR(); pv(o,vb0+(VSL),PAF(0),PAF(1),PAF(2),PAF(3)); }while(0)
  STEP(pB0,pB1,pA0,pA1,t,false,true,true);        WAIT_BAR(1); RESC(); ROT();
  if(wid>=4){
    STEP(pA0,pA1,pB0,pB1,t+1,false,true,true);    WAIT_BAR(0); RESC(); ROT();
    STEP(pB0,pB1,pA0,pA1,NT-1,false,false,false); RESC();
    FIN(pB0,pB1,sl_cur);
  } else {
    FIN(pB0,pB1,sl_prev); DMA_V(t+2,sl_next);     WAIT_BAR(0); ROT();
  }
  #undef FIN
  #undef PKW
  #undef PAF
  #undef VFR
  #undef PIN
  #undef MX3
  #undef GAPA
  #undef GAPB
  #undef EX
  #undef VRD
  #undef KRD
  #undef STEP
  #undef STEPM
  #undef ENDW
  {auto rr=__builtin_amdgcn_permlane32_swap(__float_as_uint(l_reg),__float_as_uint(l_reg),false,false);l_reg=__uint_as_float(rr[0])+__uint_as_float(rr[1]);}
  int lane_e; asm volatile("v_mbcnt_lo_u32_b32 %0, -1, 0\n\tv_mbcnt_hi_u32_b32 %0, -1, %0":"=v"(lane_e)); const int r32e=lane_e&31, hie=lane_e>>5;
  if(hie==0)wsf[32+r32e]=l_reg;asm volatile("s_waitcnt lgkmcnt(0)":::"memory");
  float rli[16];
  #pragma unroll
  for(int r=0;r<16;++r)rli[r]=__builtin_amdgcn_rcpf(wsf[32+crow(r,hie)]);
  bf16*Ow=O+(rowbase+q0+wid*QBLK)*OPITCH+h*D; const bf16*Zw=ZA+(rowbase+q0+wid*QBLK)*DM+h*D;
  { bf16*stg=(bf16*)(shm+LDS_OST)+wid*2048;
    #pragma unroll
    for(int r=0;r<16;++r){const int orow=crow(r,hie);
      #pragma unroll
      for(int d0=0;d0<2;++d0)stg[orow*64+d0*32+r32e]=__builtin_bit_cast(unsigned short,(_Float16)(o[d0][r]*rli[r]));}
    asm volatile("s_waitcnt lgkmcnt(0)":::"memory");
    int le_=lane_e; asm volatile("":"+v"(le_));
    #pragma unroll
    for(int i=0;i<4;++i){const int row=i*8+(le_>>3),ch=le_&7; const f16x8_t v=*(const f16x8_t*)(stg+row*64+ch*8), z=*(const f16x8_t*)((const char*)Zw+((unsigned)row*(DM*2)+(unsigned)ch*16)); const f16x8_t g=v*z; ATTN_STORE16((char*)Ow+((unsigned)row*(OPITCH*2)+(unsigned)ch*16),__builtin_bit_cast(u32x4,g));} }
  asm volatile("s_waitcnt lgkmcnt(0)\n\ts_barrier":::"memory");
  #undef DMA_K
  #undef DMA_V
  #undef BIASX
  #undef BIAS
  #undef MASKB
  #undef START
  #undef negm
  #undef RESC
  #undef ROT
}
constexpr int ATTN_LDS_BYTES=LDS_BYTES;
struct AttnTensors { const bf16* Q; const bf16* K; const bf16* V; bf16* O; const bf16* ZA; const unsigned* MASK; };
struct AttnUnit { int bh; int qb; };
struct StaticOrder {
  int vcu, G;
  __device__ __forceinline__ explicit StaticOrder(int grid,int block):vcu((grid%8==0)?(block%8)*(grid/8)+block/8:block),G(grid){}
  __device__ __forceinline__ bool next(int i,AttnUnit&u)const{ u.bh=vcu+(i>>3)*G; u.qb=7-(i&7); return u.bh<BATCH*NHEAD; }
  __device__ __forceinline__ void a_ready(const AttnUnit&)const{}
  __device__ __forceinline__ void done(const AttnUnit&)const{}
};
__device__ __forceinline__ int t5b(int d){ if(d<16)return d; int b=16; b+=(d>=19);b+=(d>=21);b+=(d>=24);b+=(d>=27);b+=(d>=31);b+=(d>=35);b+=(d>=40);b+=(d>=46);b+=(d>=52);b+=(d>=59);b+=(d>=67);b+=(d>=77);b+=(d>=87);b+=(d>=99);b+=(d>=113); return b; }
template<class Sched,int THRL=8,bool NOMASK=false> __device__ __forceinline__ void attn_phase(char*lds,const AttnTensors&T,const float*rel_bias,const Sched&S){
  AttnUnit u; int hcur=-1;
  for(int i=0;S.next(i,u);++i){
    const int h=u.bh%NHEAD;
    if(h!=hcur){ hcur=h; __attribute__((address_space(3))) float* tb=(__attribute__((address_space(3))) float*)((lds_cptr)lds+LDS_TB);
      int tj_=threadIdx.x; asm volatile("":"+v"(tj_));
      for(int j=tj_;j<TB_N;j+=NW*64){ const int d=383-j; tb[j]=(d<0)?0.f:(rel_bias[t5b(d)*NHEAD+h]-rel_bias[31*NHEAD+h])*1.4426950408889634f; }
      __syncthreads(); }
    S.a_ready(u); attn_unit<THRL,NOMASK>(u.bh/NHEAD,h,u.qb,T.Q,T.K,T.V,T.O,T.ZA,T.MASK,lds); S.done(u); }
}
#undef SBAR
#undef WAIT_BAR
}
__device__ __forceinline__ void p0_mod_unit(const Params& P, LAS unsigned char* lds, int unit) {
    const int tid = threadIdx.x, wave = tid >> 6, lane = tid & 63, cg = unit % 48, kq = unit / 48;
    LAS float* cond = (LAS float*)lds;
    for (int i = tid; i < 32 * 256; i += 512) { const int b = i & 31, k = i >> 5; const float cv = P.c[b * 1024 + kq * 256 + k]; cond[i] = cv / (1.f + expf(-cv)); }
    __syncthreads();
    float acc[32];
#pragma unroll
    for (int b = 0; b < 32; ++b) acc[b] = 0.f;
    const float* w = P.w_ada + (size_t)(kq * 256 + wave * 32) * 3072 + cg * 64 + lane;
#pragma unroll 4
    for (int k = 0; k < 32; ++k) {
        const float wv = w[(size_t)k * 3072];
        const LAS f32x4* cp = (const LAS f32x4*)(cond + (wave * 32 + k) * 32);
#pragma unroll
        for (int j = 0; j < 8; ++j) { const f32x4 c4 = cp[j]; acc[4 * j] += c4[0] * wv; acc[4 * j + 1] += c4[1] * wv; acc[4 * j + 2] += c4[2] * wv; acc[4 * j + 3] += c4[3] * wv; }
    }
    __syncthreads();
    LAS float* part = (LAS float*)lds;
#pragma unroll
    for (int b = 0; b < 32; ++b) part[(wave * 32 + b) * 64 + lane] = acc[b];
    __syncthreads();
    for (int o = tid; o < 2048; o += 512) { const int b = o >> 6, cl = o & 63; float s = 0.f;
#pragma unroll
        for (int wv = 0; wv < 8; ++wv) s += part[(wv * 32 + b) * 64 + cl];
        P.mod[(size_t)(kq * 32 + b) * 3072 + cg * 64 + cl] = s; }
    __syncthreads();
}
__device__ __forceinline__ void transpose_item(const float* W, int K, int N, u16* WT, int n0, int prow0, int k0, LAS float* scr, int lane) {
    const int n = n0 + (lane & 31); const bool ok = n < N;
#pragma unroll 8
    for (int i = 0; i < 32; ++i) { const int kk = 2 * i + (lane >> 5); scr[kk * 33 + (lane & 31)] = ok ? W[(size_t)(k0 + kk) * N + n] : 0.f; }
    LDS_WAIT();
    const int c = lane & 7;
#pragma unroll
    for (int j = 0; j < 4; ++j) { const int nn = (lane >> 3) + 8 * j; const LAS float* s = scr + (8 * c) * 33 + nn;
        u32x4 o; o.x = pkh(s[0], s[33]); o.y = pkh(s[2 * 33], s[3 * 33]); o.z = pkh(s[4 * 33], s[5 * 33]); o.w = pkh(s[6 * 33], s[7 * 33]);
        *(u32x4*)(WT + (size_t)(prow0 + nn) * K + k0 + 8 * c) = o; }
    LDS_WAIT();
}
__device__ __forceinline__ void p0_prologue(const Params& P, LAS unsigned char* lds) {
    const int tid = threadIdx.x, wave = tid >> 6, lane = tid & 63, G = gridDim.x;
#if MK_COOP
    if (blockIdx.x == 0) for (int i = tid; i < CTL_WORDS; i += 512) P.ctl[i] = 0u;
#endif
    for (int unit = blockIdx.x; unit < 192; unit += G) p0_mod_unit(P, lds, unit);
    LAS float* scr = (LAS float*)(lds + wave * 8448);
    const int gw = blockIdx.x * 8 + wave, NGW = G * 8;
    constexpr int I_IN = 16 * 120, I_OUT = 16 * 32, I_GLU = 8 * 16;
    for (int it = gw; it < I_IN + I_OUT + I_GLU; it += NGW) {
        int r = it;
        if (r < I_IN) { const int kb = r / 120, nb = r % 120, pn = nb >> 3, bj = (nb >> 2) & 1, wc = nb & 3;
            transpose_item(P.w_in, 1024, NIN, P.win_t, 256 * pn + 64 * wc + 32 * bj, 32 * nb, 64 * kb, scr, lane); continue; }
        r -= I_IN;
        if (r < I_OUT) { const int kb = r / 32, nb = r % 32; transpose_item(P.w_out, 1024, 1024, P.wout_t, 32 * nb, 32 * nb, 64 * kb, scr, lane); continue; }
        r -= I_OUT;
        { const int kb = r / 16, nb = r % 16; transpose_item(P.w_glu, 512, 512, P.wglu_t, 32 * nb, 32 * nb, 64 * kb, scr, lane); }
    }
    const int nb0 = G >= 200 ? 192 : 0;
    for (int i = ((int)blockIdx.x - nb0) * 512 + tid; i >= 0 && i < 2048; i += G * 512) {
        const int g = i >> 6;
        const double dt = exp((double)P.log_dt[g]), ar = P.a_re[i], ai = P.a_im[i];
        const double e = exp(ar * dt); double sn, cs; sincos(ai * dt, &sn, &cs);
        const double lr = e * cs, li = e * sn;
        const double nr = lr - 1.0, ni = li, den = ar * ar + ai * ai;
        const double cr = (nr * ar + ni * ai) / den, ci = (ni * ar - nr * ai) / den;
        P.LB[i] = (f32x2){(float)lr, (float)li};
        const int p = i & 63; const double idt = 1.0 / dt;
        if (p == 0) P.DT[g] = (float)dt;
        for (int c = 0; c < 16; ++c) { P.CCh[(size_t)(g * 16 + c) * 128 + 2 * p] = __builtin_bit_cast(u16, (h16)P.c_re[(g * 16 + c) * 64 + p]); P.CCh[(size_t)(g * 16 + c) * 128 + 2 * p + 1] = __builtin_bit_cast(u16, (h16)(-P.c_im[(g * 16 + c) * 64 + p])); }
        for (int c = 0; c < 16; ++c) { const double br = P.b_re[i * 16 + c], bi = P.b_im[i * 16 + c]; const double rr = cr * br - ci * bi, ii = cr * bi + ci * br; P.BB[i * 16 + c] = (f32x2){(float)rr, (float)ii};
            P.BBh[(size_t)(g * 128 + 2 * p) * 16 + c] = __builtin_bit_cast(u16, (h16)(float)(rr * idt)); P.BBh[(size_t)(g * 128 + 2 * p + 1) * 16 + c] = __builtin_bit_cast(u16, (h16)(float)(ii * idt)); }
    }
}
__device__ __forceinline__ void p1_norm(const Params& P) {
    const int tid = threadIdx.x, wave = tid >> 6, lane = tid & 63;
    const int gw = blockIdx.x * 8 + wave, NGW = gridDim.x * 8;
    for (int ch = gw; ch < MT / 32; ch += NGW) {
        const int row0 = ch * 32;
        const float* md = P.mod + (size_t)(row0 >> 11) * 3072;
        f32x4 gs[2][2], sh[2][2];
#pragma unroll
        for (int j = 0; j < 2; ++j)
#pragma unroll
            for (int k = 0; k < 2; ++k) { const int cc = 8 * lane + 512 * j + 4 * k;
                const f32x4 s_sh = *(const f32x4*)(P.b_ada + cc) + ((*(const f32x4*)(md + cc) + *(const f32x4*)(md + 32 * 3072 + cc)) + (*(const f32x4*)(md + 2 * 32 * 3072 + cc) + *(const f32x4*)(md + 3 * 32 * 3072 + cc)));
                const f32x4 s_sc = *(const f32x4*)(P.b_ada + 1024 + cc) + ((*(const f32x4*)(md + 1024 + cc) + *(const f32x4*)(md + 32 * 3072 + 1024 + cc)) + (*(const f32x4*)(md + 2 * 32 * 3072 + 1024 + cc) + *(const f32x4*)(md + 3 * 32 * 3072 + 1024 + cc)));
                sh[j][k] = s_sh; gs[j][k] = *(const f32x4*)(P.norm_g + cc) * (s_sc + 1.0f); }
        for (int i = 0; i < 32; i += 4) {
            const int row = row0 + i;
            f32x4 v[4][2][2]; float ss[4] = {0.f, 0.f, 0.f, 0.f};
#pragma unroll
            for (int r = 0; r < 4; ++r)
#pragma unroll
                for (int j = 0; j < 2; ++j)
#pragma unroll
                    for (int k = 0; k < 2; ++k) v[r][j][k] = __builtin_nontemporal_load((const f32x4*)(P.x + (size_t)(row + r) * 1024 + 8 * lane + 512 * j + 4 * k));
#pragma unroll
            for (int r = 0; r < 4; ++r)
#pragma unroll
                for (int j = 0; j < 2; ++j)
#pragma unroll
                    for (int k = 0; k < 2; ++k) ss[r] += (v[r][j][k][0] * v[r][j][k][0] + v[r][j][k][1] * v[r][j][k][1]) + (v[r][j][k][2] * v[r][j][k][2] + v[r][j][k][3] * v[r][j][k][3]);
#pragma unroll
            for (int r = 0; r < 4; ++r) ss[r] = wave_sum_f(ss[r]);
#pragma unroll
            for (int r = 0; r < 4; ++r) { const float rs = 1.0f / sqrtf(ss[r] * (1.0f / 1024.0f) + RMS_EPS);
#pragma unroll
                for (int j = 0; j < 2; ++j) { const f32x4 h0 = (v[r][j][0] * rs) * gs[j][0] + sh[j][0], h1 = (v[r][j][1] * rs) * gs[j][1] + sh[j][1];
                    *(u32x4*)(P.H + (size_t)(row + r) * 1024 + 8 * lane + 512 * j) = pack8(h0, h1); } }
        }
    }
}
constexpr int SROW = 528;
__device__ __forceinline__ void ssm_pair(const Params& P, LAS unsigned char* wl, int b, int g) {
    const int lane = threadIdx.x & 63, r32 = lane & 31, hi = lane >> 5, l15 = lane & 15, kq = lane >> 4;
    h16x8 bbf[4], ccf[4];
#pragma unroll
    for (int nt = 0; nt < 4; ++nt) bbf[nt] = *(const h16x8*)(P.BBh + (size_t)(g * 128 + 32 * nt + r32) * 16 + 8 * hi);
#pragma unroll
    for (int ks = 0; ks < 4; ++ks) ccf[ks] = *(const h16x8*)(P.CCh + (size_t)(g * 16 + l15) * 128 + 32 * ks + 8 * kq);
    const f32x2 lb = P.LB[g * 64 + lane];
    const float dt = P.DT[g];
    const f32x4 dsk = *(const f32x4*)(P.d_skip + 16 * g + 4 * kq);
    float hr = 0.f, hm = 0.f;
    const u16* ub = P.U + (size_t)b * SEQ * PT + 16 * g;
    u16* zb = P.ZG + (size_t)b * SEQ * 512 + 16 * g;
    h16x8 uf = *(const h16x8*)(ub + (size_t)r32 * PT + 8 * hi);
    for (int t0 = 0; t0 < SEQ; t0 += 32) {
        h16x8 un = uf;
        if (t0 + 32 < SEQ) un = *(const h16x8*)(ub + (size_t)(t0 + 32 + r32) * PT + 8 * hi);
#pragma unroll
        for (int nt = 0; nt < 4; ++nt) {
            const f32x16 s = __builtin_amdgcn_mfma_f32_32x32x16_f16(bbf[nt], uf, (f32x16){0.f, 0.f, 0.f, 0.f, 0.f, 0.f, 0.f, 0.f, 0.f, 0.f, 0.f, 0.f, 0.f, 0.f, 0.f, 0.f}, 0, 0, 0);
#pragma unroll
            for (int rq = 0; rq < 4; ++rq) *(LAS f32x4*)(wl + r32 * SROW + (32 * nt + 8 * rq + 4 * hi) * 4) = (f32x4){s[4 * rq], s[4 * rq + 1], s[4 * rq + 2], s[4 * rq + 3]};
        }
        LDS_WAIT();
#pragma unroll
        for (int tb = 0; tb < 4; ++tb) {
            f32x2 sv[8];
#pragma unroll
            for (int k = 0; k < 8; ++k) sv[k] = *(const LAS f32x2*)(wl + (8 * tb + k) * SROW + 8 * lane);
#pragma unroll
            for (int k = 0; k < 8; ++k) { const float nr = fmaf(lb[0], hr, fmaf(-lb[1], hm, sv[k][0])), ni = fmaf(lb[0], hm, fmaf(lb[1], hr, sv[k][1])); hr = nr; hm = ni;
                *(LAS unsigned*)(wl + (8 * tb + k) * SROW + 4 * lane) = pkh(hr, hm); }
        }
        LDS_WAIT();
#pragma unroll
        for (int mt = 0; mt < 2; ++mt) {
            f32x4 acc = {0.f, 0.f, 0.f, 0.f};
#pragma unroll
            for (int ks = 0; ks < 4; ++ks) { const h16x8 hf = *(const LAS h16x8*)(wl + (16 * mt + l15) * SROW + ks * 64 + kq * 16); acc = __builtin_amdgcn_mfma_f32_16x16x32_f16(ccf[ks], hf, acc, 0, 0, 0); }
            const size_t off = (size_t)(t0 + 16 * mt + l15) * 512 + 4 * kq;
            const h16x4 u4 = *(const h16x4*)(ub + (size_t)(t0 + 16 * mt + l15) * PT + 4 * kq);
            u32x2 w; w.x = pkh(gelu_fast_f(fmaf(acc[0], dt, dsk[0] * (float)u4[0])), gelu_fast_f(fmaf(acc[1], dt, dsk[1] * (float)u4[1])));
            w.y = pkh(gelu_fast_f(fmaf(acc[2], dt, dsk[2] * (float)u4[2])), gelu_fast_f(fmaf(acc[3], dt, dsk[3] * (float)u4[3])));
            *(u32x2*)(zb + off) = w;
        }
        LDS_WAIT();
        uf = un;
    }
}
constexpr int SC_STRIDE = 2052;
struct SelQ { unsigned lo, hi, T; int clo, chi, lastc, state; float lastT, mag, rdens; };
template <int NJ> __device__ __forceinline__ void sel_load(const LAS float* row, int q, int lane, float (&v)[4 * NJ], SelQ& S) {
    float s1 = 0.f, s2 = 0.f;
#pragma unroll
    for (int j = 0; j < NJ; ++j) { const int kb = 256 * j + 4 * lane; const f32x4 x = *(const LAS f32x4*)(row + kb);
#pragma unroll
        for (int e = 0; e < 4; ++e) {
            if (j >= NJ - 2) { const bool ok = (kb + e) <= q; v[4 * j + e] = ok ? x[e] : -INFINITY; const float y = ok ? x[e] : 0.f; s1 += y; s2 = fmaf(y, y, s2); }
            else { v[4 * j + e] = x[e]; s1 += x[e]; s2 = fmaf(x[e], x[e], s2); } } }
    s1 = wave_total_f(s1); s2 = wave_total_f(s2);
    const float n = (float)(q + 1), rn = __builtin_amdgcn_rcpf(n), mean = s1 * rn, var = fmaxf(s2 * rn - mean * mean, 1e-30f), rsd = __builtin_amdgcn_rsqf(var), sd = var * rsd;
    const float z = __builtin_amdgcn_logf((n - 256.f) * (1.f / 256.f)) * (0.6931471806f * 0.5875440658f);
    S.rdens = sd * __builtin_amdgcn_rcpf(n * __builtin_amdgcn_exp2f(-0.7213475204f * z * z) * 0.3989422804f);
    S.lo = 0x007FFFFFu; S.hi = 0xFF800000u; S.clo = q + 1; S.chi = 0; S.T = 0u; S.state = 0; S.lastT = mean + z * sd; S.mag = 0.f; S.lastc = 256;
}
__device__ __forceinline__ float sel_probe(SelQ& S, int it, unsigned& cand) {
    if (S.state == 0 && S.hi - S.lo <= 1u) { S.state = 2; S.T = S.lo; }
    if (S.state != 0) { cand = 0u; return INFINITY; }
    const bool lofin = S.lo != 0x007FFFFFu, hifin = S.hi != 0xFF800000u;
    if (lofin && hifin) {
        if (it >= 60) cand = S.lo + ((S.hi - S.lo) >> 1);
        else { const float flo = key2f(S.lo), fhi = key2f(S.hi);
            const float fr = (it % 3 == 2) ? 0.5f : fminf(fmaxf(((float)(S.clo - 256) + 0.5f) * __builtin_amdgcn_rcpf((float)(S.clo - S.chi)), 0.15f), 0.85f);
            cand = f2key(flo + (fhi - flo) * fr); }
    } else {
        if (it > 0) { S.mag = (S.mag == 0.f) ? 1.3f * fabsf((float)(S.lastc - 256)) * S.rdens + 1e-6f * (1.f + fabsf(S.lastT)) : S.mag * 2.f; if (!(S.mag < 1e30f)) S.mag = 1.f; S.lastT += (S.lastc > 256) ? S.mag : -S.mag; }
        cand = f2key(S.lastT);
    }
    cand = cand <= S.lo ? S.lo + 1u : cand; cand = cand >= S.hi ? S.hi - 1u : cand;
    return key2f(cand);
}
__device__ __forceinline__ void sel_update(SelQ& S, unsigned cand, float tf, int c) {
    if (S.state != 0) return;
    if (c == 256) { S.T = cand; S.state = 1; return; }
    if (c > 256) { S.lo = cand; S.clo = c; } else { S.hi = cand; S.chi = c; }
    S.lastT = tf; S.lastc = c;
}
template <int NJ> __device__ __forceinline__ void sel_finish(const float (&v)[4 * NJ], const SelQ& S, int lane, unsigned* mw) {
    const float Tf = key2f(S.T); const bool exact = S.state == 1;
    int idxcut = 4095;
    if (!exact) {
        int cgt = 0, ceq = 0;
#pragma unroll
        for (int r = 0; r < 4 * NJ; ++r) { cgt += (v[r] > Tf) ? 1 : 0; ceq += (v[r] == Tf) ? 1 : 0; }
        cgt = wave_total_i(cgt); ceq = wave_total_i(ceq);
        const int need = 256 - cgt;
        if (ceq > need) {
            int lo2 = 0, hi2 = 2047;
            while (lo2 < hi2) { const int mid = (lo2 + hi2) >> 1; int c = 0;
#pragma unroll
                for (int r = 0; r < 4 * NJ; ++r) c += (v[r] == Tf && (256 * (r >> 2) + 4 * lane + (r & 3)) <= mid) ? 1 : 0;
                c = wave_total_i(c);
                if (c >= need) hi2 = mid; else lo2 = mid + 1; }
            idxcut = lo2;
        }
    }
#pragma unroll
    for (int j = 0; j < NJ; ++j) { unsigned nib = 0u;
        if (exact) {
#pragma unroll
            for (int e = 3; e >= 0; --e) nib = nib + nib + ((v[4 * j + e] >= Tf) ? 1u : 0u);
        } else {
#pragma unroll
            for (int e = 3; e >= 0; --e) nib = nib + nib + (((v[4 * j + e] > Tf) || (v[4 * j + e] == Tf && (256 * j + 4 * lane + e) <= idxcut)) ? 1u : 0u);
        }
        int w = (int)(nib << (4 * (lane & 7)));
        w |= __builtin_amdgcn_update_dpp(0, w, 0xB1, 0xF, 0xF, false);
        w |= __builtin_amdgcn_update_dpp(0, w, 0x4E, 0xF, 0xF, false);
        w |= __builtin_amdgcn_update_dpp(0, w, 0x141, 0xF, 0xF, false);
        if ((lane & 7) == 0) mw[8 * j + (lane >> 3)] = (unsigned)w; }
}
template <int NJ> __device__ __forceinline__ void sel_query(const LAS float* row, int q, int lane, unsigned* mw) {
    float va[4 * NJ]; SelQ A;
    sel_load<NJ>(row, q, lane, va, A);
#pragma unroll 1
    for (int it = 0; it < 100; ++it) {
        unsigned ca_; const float ta = sel_probe(A, it, ca_);
        if (A.state != 0) break;
        unsigned a0 = 0u, a1 = 0u;
#pragma unroll
        for (int r = 0; r < 4 * NJ; r += 2) { a0 = __builtin_amdgcn_alignbit(a0, __float_as_uint(va[r] - ta), 31); a1 = __builtin_amdgcn_alignbit(a1, __float_as_uint(va[r + 1] - ta), 31); }
        sel_update(A, ca_, ta, 256 * NJ - wave_total_i(__builtin_popcount(a0) + __builtin_popcount(a1)));
        if (A.state != 0) break;
    }
    sel_finish<NJ>(va, A, lane, mw);
}
__device__ __forceinline__ void idx_unit(const Params& P, LAS unsigned char* lds, int unit) {
    const int tid = threadIdx.x, lane = tid & 63, wave = __builtin_amdgcn_readfirstlane(tid >> 6);
    const int b = unit >> 7, qb = unit & 127, q0 = qb * 16;
    unsigned* MW = P.mask + (size_t)(b * SEQ + q0) * 64;
    if (q0 + 15 <= 255) {
        for (int i = tid; i < 16 * 64; i += 512) { const int ql = i >> 6, w = i & 63, q = q0 + ql, lo = 32 * w;
            MW[i] = (q >= lo + 31) ? 0xFFFFFFFFu : (q < lo ? 0u : ((2u << (q - lo)) - 1u)); }
        return;
    }
    LAS float* SC = (LAS float*)lds;
    if (tid < 2) *(LAS unsigned*)(lds + LDS_MISC + 16 + 4 * tid) = 0u;
    const int ql = lane & 15, g4 = lane >> 4;
    const size_t qrow = (size_t)(b * SEQ + q0 + ql);
    h16x8 bq[8][2];
#pragma unroll
    for (int h = 0; h < 8; ++h)
#pragma unroll
        for (int ks = 0; ks < 2; ++ks) bq[h][ks] = *(const h16x8*)(P.QI + qrow * PT + 64 * h + 32 * ks + 8 * g4);
    float wq[8];
#pragma unroll
    for (int h = 0; h < 8; ++h) wq[h] = P.WI[qrow * 8 + h] * (0.5f * 0.35355339059327373f);
    h16x8 qt[2];
#pragma unroll
    for (int ks = 0; ks < 2; ++ks) {
#pragma unroll
        for (int j = 0; j < 8; ++j) { float s = 0.f;
#pragma unroll
            for (int h = 0; h < 8; ++h) s = fmaf(wq[h], (float)bq[h][ks][j], s);
            qt[ks][j] = (h16)s; } }
    const int ntile = qb + 1;
    { const u16* kpb = P.KI + (size_t)(b * SEQ + ql) * 64 + 8 * g4;
    h16x8 n0 = {}, n1 = {};
    if (wave < ntile) { n0 = *(const h16x8*)(kpb + (size_t)wave * 1024); n1 = *(const h16x8*)(kpb + (size_t)wave * 1024 + 32); }
    for (int kt = wave; kt < ntile; kt += 8) {
        const int key0 = kt * 16;
        const h16x8 a0 = n0, a1 = n1;
        if (kt + 8 < ntile) { n0 = *(const h16x8*)(kpb + (size_t)(kt + 8) * 1024); n1 = *(const h16x8*)(kpb + (size_t)(kt + 8) * 1024 + 32); }
        f32x4 sc = __builtin_amdgcn_mfma_f32_16x16x32_f16(a0, qt[0], (f32x4){0.f, 0.f, 0.f, 0.f}, 0, 0, 0);
        sc = __builtin_amdgcn_mfma_f32_16x16x32_f16(a1, qt[1], sc, 0, 0, 0);
#pragma unroll
        for (int h = 0; h < 8; ++h) { f32x4 r = __builtin_amdgcn_mfma_f32_16x16x32_f16(a0, bq[h][0], (f32x4){0.f, 0.f, 0.f, 0.f}, 0, 0, 0);
            r = __builtin_amdgcn_mfma_f32_16x16x32_f16(a1, bq[h][1], r, 0, 0, 0);
#pragma unroll
            for (int j = 0; j < 4; ++j) sc[j] = fmaf(__builtin_fabsf(r[j]), wq[h], sc[j]); }
        *(LAS f32x4*)(SC + ql * SC_STRIDE + key0 + 4 * g4) = sc;
    } }
    __syncthreads();
    constexpr int rq_ = 0;
    for (;;) {
        int qt = 0;
        if (lane == 0) qt = (int)__hip_atomic_fetch_add((LAS unsigned*)(lds + LDS_MISC + 16 + 4 * rq_), 1u, __ATOMIC_RELAXED, __HIP_MEMORY_SCOPE_WORKGROUP);
        qt = __builtin_amdgcn_readfirstlane(qt);
        if (qt >= 16) break;
        const LAS float* row = SC + qt * SC_STRIDE; unsigned* mw = MW + qt * 64; const int q = q0 + qt;
        switch (qb >> 5) {
            case 0: sel_query<2>(row, q, lane, mw); break;
            case 1: sel_query<4>(row, q, lane, mw); break;
            case 2: sel_query<6>(row, q, lane, mw); break;
            default: sel_query<8>(row, q, lane, mw); break;
        }
    }
    __syncthreads();
}
typedef __attribute__((address_space(1))) unsigned gu32;
#define XB_TMO      128
#define XB_XCNT(j)  (256  + 64 * (j))
#define XB_XSUB(j)  (1280 + 64 * (j))
#define XB_XGEN(j)  (2304 + 64 * (j))
#define XB_TOP      3328
#define XB_TOPGEN   3392
#define XCD_BAR_WORDS 3456
#define XB_SPIN_CAP (1u << 18)

__device__ __forceinline__ unsigned xb_ld(unsigned* p)              { return __hip_atomic_load(p, __ATOMIC_RELAXED, __HIP_MEMORY_SCOPE_AGENT); }
__device__ __forceinline__ unsigned xb_add(unsigned* p, unsigned v) { return __hip_atomic_fetch_add(p, v, __ATOMIC_RELAXED, __HIP_MEMORY_SCOPE_AGENT); }
__device__ __forceinline__ unsigned xb_xcc_id() { return (unsigned)__builtin_amdgcn_s_getreg((3 << 11) | 20) & 0xFu; }
#define XB_SPIN(cond, bar) do { unsigned _sp = 0; while (cond) { __builtin_amdgcn_s_sleep(1); \
    if ((++_sp & 255u) == 0u) { if (xb_ld(&(bar)[XB_TMO])) break; if (_sp > XB_SPIN_CAP) { atomicAdd(&(bar)[XB_TMO], 1u); break; } } } } while (0)

struct XcdBarrier {
    unsigned* bar; unsigned x;
    volatile LAS unsigned* st;
};

__device__ __forceinline__ XcdBarrier xcd_barrier_post(unsigned* bar, volatile LAS unsigned* st) {
    XcdBarrier b; b.bar = bar; b.x = xb_xcc_id(); b.st = st;
    if (threadIdx.x == 0) (void)xb_add(&bar[XB_XCNT(b.x)], 1u);
    return b;
}
__device__ __forceinline__ void xcd_barrier_complete(unsigned* bar, unsigned x, unsigned& nloc, unsigned& nx) {
    const unsigned G = gridDim.x * gridDim.y * gridDim.z;
    unsigned sum, cnt, mine, sp = 0u;
    for (;;) {
        sum = 0u; cnt = 0u; mine = 0u;
#pragma unroll
        for (unsigned j = 0; j < 16; ++j) { const unsigned c = xb_ld(&bar[XB_XCNT(j)]); sum += c; cnt += (c > 0u) ? 1u : 0u; mine = (j == x) ? c : mine; }
        if (sum == G) break;
        __builtin_amdgcn_s_sleep(1);
        if ((++sp & 255u) == 0u) { if (xb_ld(&bar[XB_TMO])) break; if (sp > XB_SPIN_CAP) { atomicAdd(&bar[XB_TMO], 1u); break; } }
    }
    nloc = mine > 0u ? mine : 1u; nx = cnt > 0u ? cnt : 1u;
}

__device__ __forceinline__ void xcd_barrier(const XcdBarrier& b) {
    asm volatile("s_waitcnt vmcnt(0)" ::: "memory");
    __syncthreads();
    if (threadIdx.x == 0) {
        unsigned* bar = b.bar;
        __builtin_amdgcn_s_waitcnt(0);
        unsigned nloc = b.st[0], nx = b.st[1];
        if (nloc == 0u) { xcd_barrier_complete(bar, b.x, nloc, nx); b.st[0] = nloc; b.st[1] = nx; }
        const unsigned old = xb_add(&bar[XB_XSUB(b.x)], 1u);
        const unsigned gen = old / nloc;
        if (old + 1u == (gen + 1u) * nloc) {
            __builtin_amdgcn_fence(__ATOMIC_RELEASE, "agent");
            asm volatile("s_waitcnt vmcnt(0)" ::: "memory");
            const unsigned og = xb_add(&bar[XB_TOP], 1u);
            const unsigned tg = og / nx;
            if (og + 1u == (tg + 1u) * nx) xb_add(&bar[XB_TOPGEN], 1u);
            else XB_SPIN(xb_ld(&bar[XB_TOPGEN]) == tg, bar);
            __builtin_amdgcn_fence(__ATOMIC_ACQUIRE, "agent");
            xb_add(&bar[XB_XGEN(b.x)], 1u);
            asm volatile("s_waitcnt vmcnt(0)" ::: "memory");
        } else {
            XB_SPIN(xb_ld(&bar[XB_XGEN(b.x)]) == gen, bar);
            __builtin_amdgcn_fence(__ATOMIC_ACQUIRE, "agent");
            asm volatile("s_waitcnt vmcnt(0)" ::: "memory");
        }
    }
    __syncthreads();
}

namespace cg = cooperative_groups;
#ifndef MK_LAUNCHES
#define MK_LAUNCHES 1
#endif
#ifndef MK_COOP
#define MK_COOP 0
#endif
constexpr int N_PHASES = 6;
__global__ void __launch_bounds__(512, 2) mk_fwd(Params P_arg, int ph_lo, int ph_hi) {
#define P (*(const Params*)__builtin_amdgcn_kernarg_segment_ptr())
    (void)P_arg;
    extern __shared__ __attribute__((aligned(16))) unsigned char lds_raw[];
    LAS unsigned char* lds = (LAS unsigned char*)lds_raw;
#if MK_COOP
    cg::grid_group grid = cg::this_grid();
#endif
    if (threadIdx.x < 2) *(volatile LAS unsigned*)(lds + LDS_MISC + 32 + 4 * threadIdx.x) = 0u;
    __syncthreads();
#if MK_COOP
    XcdBarrier xbar; xbar.bar = P.ctl + CTL_BAR; xbar.x = 0; xbar.st = (volatile LAS unsigned*)(lds + LDS_MISC + 32);
#else
    XcdBarrier xbar = xcd_barrier_post(P.ctl + CTL_BAR, (volatile LAS unsigned*)(lds + LDS_MISC + 32));
#endif
    const int wave = threadIdx.x >> 6;
#define IN(k) (ph_lo <= (k) && (k) < ph_hi)
#if MK_COOP
#define SEAM(k) do { if (IN(k) && IN((k) + 1)) { if ((k) == 0) { grid.sync(); xbar = xcd_barrier_post(P.ctl + CTL_BAR, (volatile LAS unsigned*)(lds + LDS_MISC + 32)); } else { xcd_barrier(xbar); } } } while (0)
#else
#define SEAM(k) do { if (IN(k) && IN((k) + 1)) xcd_barrier(xbar); } while (0)
#endif
    if (IN(0)) p0_prologue(P, lds);
    SEAM(0);
    if (IN(1)) p1_norm(P);
    SEAM(1);
    if (IN(2)) { pg8::Gemm g{P.H, P.win_t, MT, NPAD, 1024}; pg8::StaticOrder S; S.init(MT, NPAD, gridDim.x, (int)blockIdx.x, 4); EpiProj E{P};
        pg8::gemm_phase<EpiProj, pg8::StaticOrder, true, true>(lds, g, S, E); }
    SEAM(2);
    if (IN(3)) {
        for (int pr = blockIdx.x * 8 + wave; pr < 1024; pr += gridDim.x * 8) ssm_pair(P, lds + wave * (32 * SROW), pr >> 5, pr & 31);
        for (;;) {
            __syncthreads();
            if (threadIdx.x == 0) *(volatile LAS unsigned*)(lds + LDS_MISC) = atomicAdd(P.ctl, 1u);
            __syncthreads();
            const unsigned ord = *(volatile LAS unsigned*)(lds + LDS_MISC);
            if (ord >= 4096u) break;
            idx_unit(P, lds, (int)((ord & 31u) * 128u + (127u - (ord >> 5))));
        }
    }
    SEAM(3);
    if (IN(4)) {
        { const attn_body::AttnTensors AT{P.Q, P.K, P.V, P.H + 512, P.ZA, P.mask}; const attn_body::StaticOrder S((int)gridDim.x, (int)blockIdx.x);
          attn_body::attn_phase<attn_body::StaticOrder>((char*)lds_raw, AT, P.rel_bias, S); }
        __syncthreads();
        pg8::Gemm g{P.ZG, P.wglu_t, MT, 512, 512}; pg8::StaticOrder S; S.init(MT, 512, gridDim.x, (int)blockIdx.x); EpiGlu E{P};
        pg8::gemm_phase<EpiGlu, pg8::StaticOrder, true, true>(lds, g, S, E);
    }
    SEAM(4);
    if (IN(5)) { pg8::Gemm g{P.H, P.wout_t, MT, 1024, 1024}; pg8::StaticOrder S; S.init(MT, 1024, gridDim.x, (int)blockIdx.x); EpiOut E{P};
        pg8::gemm_phase<EpiOut, pg8::StaticOrder, true, true>(lds, g, S, E); }
#undef IN
#undef SEAM
#undef P
}

extern "C" void kernel_launch(void* const* d_in, const int* in_sizes, int n_in, void* d_out, int out_size, void* d_ws, size_t ws_size, hipStream_t stream) {
    static int grid_blocks = 0;
    if (!grid_blocks) {
        if (n_in != 20 || in_sizes[0] != MT * DM || out_size != MT * DM || ws_size < WS_END) { fprintf(stderr, "kernel_launch: unexpected shapes (n_in %d, in0 %d, out %d, ws %zu)\n", n_in, n_in > 0 ? in_sizes[0] : -1, out_size, ws_size); grid_blocks = -1; return; }
        if (hipFuncSetAttribute((const void*)mk_fwd, hipFuncAttributeMaxDynamicSharedMemorySize, LDS_BYTES) != hipSuccess) { fprintf(stderr, "kernel_launch: hipFuncSetAttribute failed\n"); grid_blocks = -1; return; }
        int dev = 0, cus = 0, per_cu = 0;
        (void)hipGetDevice(&dev); (void)hipDeviceGetAttribute(&cus, hipDeviceAttributeMultiprocessorCount, dev);
        (void)hipOccupancyMaxActiveBlocksPerMultiprocessor(&per_cu, (const void*)mk_fwd, 512, LDS_BYTES);
        if (per_cu < 1) { fprintf(stderr, "kernel_launch: occupancy query says %d blocks per CU\n", per_cu); grid_blocks = -1; return; }
        grid_blocks = cus;
    }
    if (grid_blocks < 0) return;
    Params P{};
    const float* const* in = (const float* const*)d_in;
    P.x = in[0]; P.c = in[1]; P.rel_bias = in[2]; P.norm_g = in[3]; P.w_ada = in[4]; P.b_ada = in[5]; P.w_in = in[6]; P.q_gain = in[7]; P.k_gain = in[8]; P.a_re = in[9]; P.a_im = in[10];
    P.log_dt = in[11]; P.b_re = in[12]; P.b_im = in[13]; P.c_re = in[14]; P.c_im = in[15]; P.d_skip = in[16]; P.w_glu = in[17]; P.b_glu = in[18]; P.w_out = in[19];
    unsigned char* ws = (unsigned char*)d_ws;
    P.out = (float*)d_out; P.mod = (float*)(ws + WS_MOD); P.win_t = (u16*)(ws + WS_WIN); P.wout_t = (u16*)(ws + WS_WOUT); P.wglu_t = (u16*)(ws + WS_WGLU);
    P.LB = (f32x2*)(ws + WS_LB); P.BB = (f32x2*)(ws + WS_BB); P.H = (u16*)(ws + WS_H); P.U = (u16*)(ws + WS_U); P.ZS = (u16*)(ws + WS_ZS); P.Q = (u16*)(ws + WS_Q); P.K = (u16*)(ws + WS_K);
    P.V = (u16*)(ws + WS_V); P.ZA = (u16*)(ws + WS_ZA); P.QI = (u16*)(ws + WS_QI); P.KI = (u16*)(ws + WS_KI); P.WI = (float*)(ws + WS_WI); P.ZG = (u16*)(ws + WS_ZG); P.mask = (unsigned*)(ws + WS_MASK);
    P.BBh = (u16*)(ws + WS_BBH); P.CCh = (u16*)(ws + WS_CCH); P.DT = (float*)(ws + WS_DT); P.ctl = (unsigned*)ws;
#if MK_LAUNCHES == 1
    int lo = 0, hi = N_PHASES;
    void* args[] = {&P, &lo, &hi};
#if MK_COOP
    const hipError_t e = hipLaunchCooperativeKernel((const void*)mk_fwd, dim3(grid_blocks), dim3(512), args, LDS_BYTES, stream);
    if (e != hipSuccess) fprintf(stderr, "kernel_launch: cooperative launch failed: %s (grid %d)\n", hipGetErrorString(e), grid_blocks);
#else
    (void)args;
    if (hipMemsetAsync(d_ws, 0, (size_t)CTL_WORDS * 4, stream) != hipSuccess) { fprintf(stderr, "kernel_launch: hipMemsetAsync failed\n"); return; }
    hipLaunchKernelGGL(mk_fwd, dim3(grid_blocks), dim3(512), LDS_BYTES, stream, P, lo, hi);
#endif
#else
    for (int ph = 0; ph < N_PHASES; ++ph) hipLaunchKernelGGL(mk_fwd, dim3(grid_blocks), dim3(512), LDS_BYTES, stream, P, ph, ph + 1);
#endif
}
```

```cpp
#include <hip/hip_runtime.h>
#include <hip/hip_cooperative_groups.h>
#include <cstdio>
#include <cstdint>
#include <cmath>
namespace pg8 {
#define PG8_LAS __attribute__((address_space(3)))
typedef unsigned short bf16_t;
typedef _Float16 bf16x8 __attribute__((ext_vector_type(8)));
typedef float f32x4 __attribute__((ext_vector_type(4)));
typedef unsigned u32x4 __attribute__((ext_vector_type(4)));
constexpr int BM = 256, BK = 64, HALF = 128, HTB = HALF * BK * 2  , STAGE_BYTES = 8 * HTB, NXCD = 8, WGM = 2;

__host__ __device__ __forceinline__ int lds_byte(int r, int c) { const int st = (r >> 4) * 2 + (c >> 5), rr = r & 15, cc = c & 31, ob = rr * 64 + cc * 2; return st * 1024 + (ob ^ (((ob >> 9) & 1) << 5)); }
__host__ __device__ __forceinline__ void stage_rc(int b, int& R, int& C) { const int st = b / 1024, sb = b % 1024, swz = sb ^ (((sb >> 9) & 1) << 5); R = (st >> 1) * 16 + swz / 64; C = (st & 1) * 32 + (swz % 64) / 2; }
__host__ __device__ __forceinline__ int perm32(int rho) { const int n = rho >> 4, i = rho & 15; return 8 * (i >> 2) + 4 * n + (i & 3); }

struct Unit { int pm, pn; };
struct Gemm { const bf16_t* A; const bf16_t* Bt; int M, N, K; };

struct StaticOrder {
    int nM, nN, nwg, G, c, wgm;
    __host__ __device__ void init(int M, int N, int G_, int c_, int wgm_ = WGM) { nM = M / BM; nN = N / BM; nwg = nM * nN; G = G_; c = c_; wgm = wgm_; }
    __host__ __device__ bool next(int i, Unit& u) const {
        const long L = (long)i * G + c; if (L >= nwg) return false;
        int wgid = (int)L; { const int q = nwg / NXCD, r = nwg % NXCD, xcd = wgid % NXCD, off = wgid / NXCD; wgid = (xcd < r ? xcd * (q + 1) : r * (q + 1) + (xcd - r) * q) + off; }
        const int nig = wgm * nN, gid = wgid / nig, fm = gid * wgm, gsz = (nM - fm) < wgm ? (nM - fm) : wgm;
        u.pm = fm + ((wgid % nig) % gsz); u.pn = (wgid % nig) / gsz; return true;
    }
    __device__ __forceinline__ void a_ready(const Unit&) const {}
    __device__ __forceinline__ void done(const Unit&) const {}
};

template <class Epi, class Sched, bool ALIGN_EPI = false, bool SP2 = false>
__device__ __forceinline__ void gemm_phase(PG8_LAS unsigned char* lds, const Gemm g, const Sched& S, const Epi& E, const int tid_in = -1) {
    const int tid = tid_in >= 0 ? tid_in : (int)threadIdx.x, wid = __builtin_amdgcn_readfirstlane(tid >> 6), lane = tid & 63, wr = wid >> 2, wc = wid & 3, fr = lane & 15, fq = lane >> 4;
    const int K = g.K, nt = K / BK;
    unsigned voffA[2], voffB[2];
#pragma unroll
    for (int i = 0; i < 2; ++i) { int R, C; stage_rc(tid * 16 + i * 8192, R, C); const int Rb = Epi::PERM ? ((R & ~31) + perm32(R & 31)) : R;
        voffA[i] = (unsigned)(R * K + C) * 2u; voffB[i] = (unsigned)(Rb * K + C) * 2u; }
    const size_t kstep = (size_t)(BK * 2);
    const size_t hstep = (size_t)HALF * K * 2;
    const size_t tstep = 2 * hstep;
    const unsigned ldsw = (unsigned)wid * 1024u;
    const int aoff = lds_byte(wr * 64 + fr, fq * 8), boff = lds_byte(wc * 32 + fr, fq * 8);
#define PG8_SA(b, h) (((b) * 2 + (h)) * HTB)
#define PG8_SB(b, h) ((4 + (b) * 2 + (h)) * HTB)
#define PG8_STAGE(bufoff, gbase, voff) do { _Pragma("unroll") for (int _i = 0; _i < 2; ++_i) \
        __builtin_amdgcn_global_load_lds((const unsigned*)((const char*)(gbase) + (voff)[_i]), (PG8_LAS unsigned*)(lds + (bufoff) + ldsw + _i * 8192), 16, 0, 0); } while (0)
#define PG8_LDA(dst, b, h) do { _Pragma("unroll") for (int m = 0; m < 4; ++m) _Pragma("unroll") for (int k = 0; k < 2; ++k) dst[m][k] = *(const PG8_LAS bf16x8*)(lds + PG8_SA(b, h) + aoff + m * 2048 + k * 1024); } while (0)
#define PG8_LDB(dst, b, h) do { _Pragma("unroll") for (int n = 0; n < 2; ++n) _Pragma("unroll") for (int k = 0; k < 2; ++k) dst[n][k] = *(const PG8_LAS bf16x8*)(lds + PG8_SB(b, h) + boff + n * 2048 + k * 1024); } while (0)
#define PG8_MMA(ai, bj, At, Bt) do { __builtin_amdgcn_s_setprio(1); _Pragma("unroll") for (int m = 0; m < 4; ++m) _Pragma("unroll") for (int n = 0; n < 2; ++n) _Pragma("unroll") for (int k = 0; k < 2; ++k) \
        acc[ai][bj][m][n] = __builtin_amdgcn_mfma_f32_16x16x32_f16(Bt[n][k], At[m][k], acc[ai][bj][m][n], 0, 0, 0); __builtin_amdgcn_s_setprio(0); } while (0)
#define PG8_WAIT_V(n) asm volatile("s_waitcnt vmcnt(" #n ")" ::: "memory")
#define PG8_WAIT_L(n) asm volatile("s_waitcnt lgkmcnt(" #n ")" ::: "memory")
#define PG8_BAR __builtin_amdgcn_s_barrier()
#define PG8_SCHED __builtin_amdgcn_sched_barrier(0)
    Unit cur, nxt; int ui = 0;
    if (!S.next(0, cur)) return;
    f32x4 acc[2][2][4][2];
#pragma unroll
    for (int a = 0; a < 2; ++a)
#pragma unroll
        for (int b = 0; b < 2; ++b)
#pragma unroll
            for (int m = 0; m < 4; ++m)
#pragma unroll
                for (int n = 0; n < 2; ++n) acc[a][b][m][n] = (f32x4){0.f, 0.f, 0.f, 0.f};
    bf16x8 At[4][2], B0[2][2], B1[2][2];
    const char* cA = (const char*)g.A + (size_t)cur.pm * tstep; const char* cB = (const char*)g.Bt + (size_t)cur.pn * tstep;
    S.a_ready(cur);
    if constexpr (SP2) {
        PG8_STAGE(PG8_SB(0, 0), cB, voffB); PG8_STAGE(PG8_SB(0, 1), cB + hstep, voffB); PG8_STAGE(PG8_SA(0, 0), cA, voffA); PG8_STAGE(PG8_SA(0, 1), cA + hstep, voffA);
        if (wr == 1) PG8_BAR;
        PG8_WAIT_V(2); PG8_BAR;
        PG8_STAGE(PG8_SB(1, 0), cB + kstep, voffB); PG8_STAGE(PG8_SA(1, 0), cA + kstep, voffA); PG8_STAGE(PG8_SB(1, 1), cB + hstep + kstep, voffB);
        PG8_WAIT_V(6); PG8_BAR;
    } else {
        PG8_STAGE(PG8_SB(0, 0), cB, voffB); PG8_STAGE(PG8_SA(0, 0), cA, voffA); PG8_STAGE(PG8_SB(0, 1), cB + hstep, voffB); PG8_STAGE(PG8_SA(0, 1), cA + hstep, voffA);
        if (wr == 1) PG8_BAR;
        PG8_WAIT_V(4); PG8_BAR;
        PG8_STAGE(PG8_SB(1, 0), cB + kstep, voffB); PG8_STAGE(PG8_SA(1, 0), cA + kstep, voffA); PG8_STAGE(PG8_SB(1, 1), cB + hstep + kstep, voffB);
        PG8_WAIT_V(6); PG8_BAR;
    }
    for (;;) {
        const bool has_next = S.next(ui + 1, nxt);
        const char* nA = has_next ? (const char*)g.A + (size_t)nxt.pm * tstep : cA; const char* nB = has_next ? (const char*)g.Bt + (size_t)nxt.pn * tstep : cB;
        for (int t = 0; t < nt; t += 2) {
            const bool last = (t == nt - 2);
            const char* a1 = cA + (size_t)(t + 1) * kstep;
            const char* a2 = last ? nA : cA + (size_t)(t + 2) * kstep; const char* b2 = last ? nB : cB + (size_t)(t + 2) * kstep;
            const char* a3 = a2 + kstep; const char* b3 = b2 + kstep;
            if (last && has_next) S.a_ready(nxt);
            if constexpr (SP2) {
            PG8_LDB(B0, 0, 0); PG8_LDB(B1, 0, 1); PG8_SCHED; PG8_LDA(At, 0, 0); PG8_STAGE(PG8_SA(1, 1), a1 + hstep, voffA);
            PG8_WAIT_V(8); PG8_WAIT_L(0); PG8_BAR; PG8_MMA(0, 0, At, B0); PG8_MMA(0, 1, At, B1); PG8_BAR; PG8_SCHED;
            PG8_LDA(At, 0, 1); PG8_STAGE(PG8_SB(0, 0), b2, voffB); PG8_STAGE(PG8_SB(0, 1), b2 + hstep, voffB); PG8_STAGE(PG8_SA(0, 0), a2, voffA);
            PG8_WAIT_V(8); PG8_WAIT_L(0); PG8_BAR; PG8_MMA(1, 0, At, B0); PG8_MMA(1, 1, At, B1); PG8_BAR; PG8_SCHED;
            PG8_LDB(B0, 1, 0); PG8_LDB(B1, 1, 1); PG8_SCHED; PG8_LDA(At, 1, 0); PG8_STAGE(PG8_SA(0, 1), a2 + hstep, voffA);
            PG8_WAIT_V(8); PG8_WAIT_L(0); PG8_BAR; PG8_MMA(0, 0, At, B0); PG8_MMA(0, 1, At, B1); PG8_BAR; PG8_SCHED;
            PG8_LDA(At, 1, 1); PG8_STAGE(PG8_SB(1, 0), b3, voffB); PG8_STAGE(PG8_SB(1, 1), b3 + hstep, voffB); PG8_STAGE(PG8_SA(1, 0), a3, voffA);
            PG8_WAIT_V(8); PG8_WAIT_L(0); PG8_BAR; PG8_MMA(1, 0, At, B0); PG8_MMA(1, 1, At, B1); PG8_BAR; PG8_SCHED;
            } else {
            PG8_LDB(B0, 0, 0); PG8_SCHED; PG8_LDA(At, 0, 0); PG8_STAGE(PG8_SA(1, 1), a1 + hstep, voffA);
            PG8_WAIT_L(8); PG8_BAR; PG8_WAIT_L(0); PG8_MMA(0, 0, At, B0); PG8_BAR; PG8_SCHED;
            PG8_LDB(B1, 0, 1); PG8_STAGE(PG8_SB(0, 0), b2, voffB);
            PG8_BAR; PG8_WAIT_L(0); PG8_MMA(0, 1, At, B1); PG8_BAR;
            PG8_LDA(At, 0, 1); PG8_STAGE(PG8_SA(0, 0), a2, voffA);
            PG8_BAR; PG8_WAIT_L(0); PG8_MMA(1, 0, At, B0); PG8_BAR; PG8_SCHED;
            PG8_STAGE(PG8_SB(0, 1), b2 + hstep, voffB);
            PG8_WAIT_V(6); PG8_BAR; PG8_MMA(1, 1, At, B1); PG8_BAR;
            PG8_LDB(B0, 1, 0); PG8_SCHED; PG8_LDA(At, 1, 0); PG8_STAGE(PG8_SA(0, 1), a2 + hstep, voffA);
            PG8_WAIT_L(8); PG8_BAR; PG8_WAIT_L(0); PG8_MMA(0, 0, At, B0); PG8_BAR; PG8_SCHED;
            PG8_LDB(B1, 1, 1); PG8_STAGE(PG8_SB(1, 0), b3, voffB);
            PG8_BAR; PG8_WAIT_L(0); PG8_MMA(0, 1, At, B1); PG8_BAR;
            PG8_LDA(At, 1, 1); PG8_STAGE(PG8_SA(1, 0), a3, voffA);
            PG8_BAR; PG8_WAIT_L(0); PG8_MMA(1, 0, At, B0); PG8_BAR; PG8_SCHED;
            PG8_STAGE(PG8_SB(1, 1), b3 + hstep, voffB);
            PG8_WAIT_V(6); PG8_BAR; PG8_MMA(1, 1, At, B1); PG8_BAR;
            }
        }
        if constexpr (ALIGN_EPI) { if (wr == 0) PG8_BAR; }
        if constexpr (!Epi::AFTER_DRAIN) { E(acc, cur, wr, wc, fr, fq); S.done(cur); }
        if (!has_next) break;
#pragma unroll
        for (int a = 0; a < 2; ++a)
#pragma unroll
            for (int b = 0; b < 2; ++b)
#pragma unroll
                for (int m = 0; m < 4; ++m)
#pragma unroll
                    for (int n = 0; n < 2; ++n) acc[a][b][m][n] = (f32x4){0.f, 0.f, 0.f, 0.f};
        cur = nxt; cA = nA; cB = nB; ++ui;
        if constexpr (ALIGN_EPI) { if (wr == 1) PG8_BAR; }
    }
    PG8_WAIT_V(0);
    if constexpr (!ALIGN_EPI) { if (wr == 0) PG8_BAR; }
    PG8_BAR;
    if constexpr (Epi::AFTER_DRAIN) { E.fused(acc, cur, wr, wc, fr, fq, lds, wid, lane); S.done(cur); }
#undef PG8_SA
#undef PG8_SB
#undef PG8_STAGE
#undef PG8_LDA
#undef PG8_LDB
#undef PG8_MMA
#undef PG8_WAIT_V
#undef PG8_WAIT_L
#undef PG8_BAR
#undef PG8_SCHED
}
}
#ifndef MK_COOP
#define MK_COOP 0
#endif
#define LAS __attribute__((address_space(3)))
typedef unsigned short u16;
typedef _Float16 h16;
typedef _Float16 h16x8 __attribute__((ext_vector_type(8)));
typedef _Float16 h16x4 __attribute__((ext_vector_type(4)));
typedef _Float16 h16x2 __attribute__((ext_vector_type(2)));
typedef float f32x2 __attribute__((ext_vector_type(2)));
typedef float f32x4 __attribute__((ext_vector_type(4)));
typedef unsigned u32x4 __attribute__((ext_vector_type(4)));
typedef unsigned u32x2 __attribute__((ext_vector_type(2)));
typedef float f32x16 __attribute__((ext_vector_type(16)));

constexpr int NB = 32, SEQ = 2048, DM = 1024, MT = NB * SEQ, NIN = 3656, NPAD = 3840;
constexpr float RMS_EPS = 1e-6f, LOG2E = 1.4426950408889634f, QSCALE = 0.125f * 1.4426950408889634f;
constexpr size_t MiB = 1u << 20;
constexpr size_t WS_MOD = 20 * MiB  , WS_WIN = 2 * MiB, WS_WOUT = 10 * MiB, WS_WGLU = 12 * MiB, WS_LB = 13 * MiB, WS_BB = 14 * MiB, WS_BBH = 15 * MiB, WS_CCH = 16 * MiB, WS_DT = 17 * MiB;
constexpr int PT = 520;
constexpr size_t WS_H = 32 * MiB, WS_U = 160 * MiB, WS_ZS = 225 * MiB, WS_Q = 290 * MiB, WS_K = 355 * MiB, WS_V = 420 * MiB, WS_ZA = 485 * MiB;
constexpr size_t WS_QI = 550 * MiB, WS_KI = 615 * MiB, WS_WI = 623 * MiB, WS_ZG = 626 * MiB, WS_MASK = 690 * MiB, WS_END = 706 * MiB;
constexpr int CTL_BAR = 1024, CTL_WORDS = 1024 + 3456;
constexpr int LDS_BYTES = 147456, LDS_MISC = 143360;

struct Params {
    const float *x, *c, *rel_bias, *norm_g, *w_ada, *b_ada, *w_in, *q_gain, *k_gain, *a_re, *a_im, *log_dt, *b_re, *b_im, *c_re, *c_im, *d_skip, *w_glu, *b_glu, *w_out;
    float* out;
    float* mod;
    u16 *win_t, *wout_t, *wglu_t;
    f32x2 *LB, *BB;
    u16 *BBh, *CCh;
    float* DT;
    unsigned* ctl;
    u16 *H;
    u16 *U, *ZS, *Q, *K, *V, *ZA, *QI, *KI, *ZG;
    float* WI;
    unsigned* mask;
};

__device__ __forceinline__ unsigned pkh(float a, float b) { f32x2 v = {a, b}; h16x2 h = __builtin_convertvector(v, h16x2); return __builtin_bit_cast(unsigned, h); }
__device__ __forceinline__ u32x4 pack8(const f32x4 a, const f32x4 b) { u32x4 w; w.x = pkh(a[0], a[1]); w.y = pkh(a[2], a[3]); w.z = pkh(b[0], b[1]); w.w = pkh(b[2], b[3]); return w; }
__device__ __forceinline__ float silu_f(float v) { return v * __builtin_amdgcn_rcpf(1.f + __builtin_amdgcn_exp2f(-1.4426950408889634f * v)); }
__device__ __forceinline__ float sigmoid_f(float v) { return __builtin_amdgcn_rcpf(1.f + __builtin_amdgcn_exp2f(-1.4426950408889634f * v)); }
__device__ __forceinline__ float gelu_tanh_f(float v) { const float t = tanhf(0.7978845608028654f * (v + 0.044715f * v * v * v)); return 0.5f * v * (1.f + t); }
__device__ __forceinline__ float gelu_fast_f(float v) { const float a = v * (1.5957691216057308f + 0.07135481627260025f * v * v); return v * __builtin_amdgcn_rcpf(1.f + __builtin_amdgcn_exp2f(-1.4426950408889634f * a)); }
__device__ __forceinline__ int wave_total_i(int v) {
    v += __builtin_amdgcn_update_dpp(0, v, 0x111, 0xF, 0xF, true); v += __builtin_amdgcn_update_dpp(0, v, 0x112, 0xF, 0xF, true);
    v += __builtin_amdgcn_update_dpp(0, v, 0x114, 0xF, 0xF, true); v += __builtin_amdgcn_update_dpp(0, v, 0x118, 0xF, 0xF, true);
    v += __builtin_amdgcn_update_dpp(0, v, 0x142, 0xA, 0xF, true); v += __builtin_amdgcn_update_dpp(0, v, 0x143, 0xC, 0xF, true);
    return __builtin_amdgcn_readlane(v, 63);
}
__device__ __forceinline__ float wave_total_f(float v) {
    v += __builtin_bit_cast(float, __builtin_amdgcn_update_dpp(0, __builtin_bit_cast(int, v), 0x111, 0xF, 0xF, true)); v += __builtin_bit_cast(float, __builtin_amdgcn_update_dpp(0, __builtin_bit_cast(int, v), 0x112, 0xF, 0xF, true));
    v += __builtin_bit_cast(float, __builtin_amdgcn_update_dpp(0, __builtin_bit_cast(int, v), 0x114, 0xF, 0xF, true)); v += __builtin_bit_cast(float, __builtin_amdgcn_update_dpp(0, __builtin_bit_cast(int, v), 0x118, 0xF, 0xF, true));
    v += __builtin_bit_cast(float, __builtin_amdgcn_update_dpp(0, __builtin_bit_cast(int, v), 0x142, 0xA, 0xF, true)); v += __builtin_bit_cast(float, __builtin_amdgcn_update_dpp(0, __builtin_bit_cast(int, v), 0x143, 0xC, 0xF, true));
    return __builtin_bit_cast(float, __builtin_amdgcn_readlane(__builtin_bit_cast(int, v), 63));
}
__device__ __forceinline__ unsigned wave_max_u(unsigned v) {
#pragma unroll
    for (int o = 1; o < 64; o <<= 1) { const unsigned t = (unsigned)__shfl_xor((int)v, o); v = t > v ? t : v; }
    return v;
}
__device__ __forceinline__ unsigned wave_min_u(unsigned v) {
#pragma unroll
    for (int o = 1; o < 64; o <<= 1) { const unsigned t = (unsigned)__shfl_xor((int)v, o); v = t < v ? t : v; }
    return v;
}
__device__ __forceinline__ unsigned f2key(float f) { const unsigned b = __builtin_bit_cast(unsigned, f); return (b & 0x80000000u) ? ~b : (b | 0x80000000u); }
__device__ __forceinline__ float key2f(unsigned k) { const unsigned b = (k & 0x80000000u) ? (k ^ 0x80000000u) : ~k; return __builtin_bit_cast(float, b); }

__device__ __forceinline__ int t5_bucket(int d) {
    if (d < 16) return d;
    int b = 16;
    b += (d >= 19); b += (d >= 21); b += (d >= 24); b += (d >= 27); b += (d >= 31); b += (d >= 35); b += (d >= 40); b += (d >= 46);
    b += (d >= 52); b += (d >= 59); b += (d >= 67); b += (d >= 77); b += (d >= 87); b += (d >= 99); b += (d >= 113);
    return b;
}
__device__ __forceinline__ int wave_sum_i(int v) {
#pragma unroll
    for (int o = 1; o < 64; o <<= 1) v += __shfl_xor(v, o);
    return v;
}
__device__ __forceinline__ float wave_sum_f(float v) {
#pragma unroll
    for (int o = 1; o < 64; o <<= 1) v += __shfl_xor(v, o);
    return v;
}
#define LDS_WAIT() asm volatile("s_waitcnt lgkmcnt(0)" ::: "memory")

struct EpiProj {
    static constexpr bool PERM = true, AFTER_DRAIN = false;
    Params P;
    __device__ __forceinline__ void operator()(const f32x4 (&acc)[2][2][4][2], const pg8::Unit& u, int wr, int wc, int fr, int fq) const {
        const int pn = u.pn, kind = pn >> 1;
        const int row0 = u.pm * 256 + wr * 64 + fr;
        const int lc = (pn & 1) * 256 + 64 * wc + 8 * fq;
        if (pn == 14) {
            if (wc == 0) {
#pragma unroll
                for (int ai = 0; ai < 2; ++ai)
#pragma unroll
                    for (int m = 0; m < 4; ++m) { const size_t row = (size_t)(row0 + ai * 128 + m * 16);
#pragma unroll
                        for (int bj = 0; bj < 2; ++bj) *(u32x4*)(P.KI + row * 64 + 32 * bj + 8 * fq) = pack8(acc[ai][bj][m][0], acc[ai][bj][m][1]); }
            } else if (wc == 1 && fq == 0) {
#pragma unroll
                for (int ai = 0; ai < 2; ++ai)
#pragma unroll
                    for (int m = 0; m < 4; ++m) { const size_t row = (size_t)(row0 + ai * 128 + m * 16);
                        *(f32x4*)(P.WI + row * 8) = acc[ai][0][m][0]; *(f32x4*)(P.WI + row * 8 + 4) = acc[ai][0][m][1]; }
            }
            return;
        }
        if (kind == 2 || kind == 3) {
            const float* gp = (kind == 2 ? P.q_gain : P.k_gain) + 8 * fq;
            const float sc = (kind == 2) ? QSCALE : 1.f;
            f32x4 gv[2][2];
#pragma unroll
            for (int bj = 0; bj < 2; ++bj)
#pragma unroll
                for (int n = 0; n < 2; ++n) gv[bj][n] = *(const f32x4*)(gp + 32 * bj + 4 * n) * sc;
            u16* O = (kind == 2 ? P.Q : P.K);
#pragma unroll
            for (int ai = 0; ai < 2; ++ai)
#pragma unroll
                for (int m = 0; m < 4; ++m) { const size_t row = (size_t)(row0 + ai * 128 + m * 16);
                    float ss = 0.f;
#pragma unroll
                    for (int bj = 0; bj < 2; ++bj)
#pragma unroll
                        for (int n = 0; n < 2; ++n) { const f32x4 v = acc[ai][bj][m][n]; ss += (v[0] * v[0] + v[1] * v[1]) + (v[2] * v[2] + v[3] * v[3]); }
                    ss += __shfl_xor(ss, 16); ss += __shfl_xor(ss, 32);
                    const float rs = __builtin_amdgcn_rsqf(ss * (1.0f / 64.0f) + RMS_EPS);
#pragma unroll
                    for (int bj = 0; bj < 2; ++bj) *(u32x4*)(O + row * PT + lc + 32 * bj) = pack8(acc[ai][bj][m][0] * rs * gv[bj][0], acc[ai][bj][m][1] * rs * gv[bj][1]); }
            return;
        }
        u16* O = kind == 0 ? P.U : kind == 1 ? P.ZS : kind == 4 ? P.V : kind == 5 ? P.ZA : P.QI;
        const bool act = (kind == 1 || kind == 5);
#pragma unroll
        for (int ai = 0; ai < 2; ++ai)
#pragma unroll
            for (int m = 0; m < 4; ++m) { const size_t row = (size_t)(row0 + ai * 128 + m * 16);
#pragma unroll
                for (int bj = 0; bj < 2; ++bj) { f32x4 v0 = acc[ai][bj][m][0], v1 = acc[ai][bj][m][1];
                    if (act) {
#pragma unroll
                        for (int e = 0; e < 4; ++e) { v0[e] = silu_f(v0[e]); v1[e] = silu_f(v1[e]); } }
                    *(u32x4*)(O + row * PT + lc + 32 * bj) = pack8(v0, v1); } }
    }
};
struct EpiGlu {
    static constexpr bool PERM = true, AFTER_DRAIN = false;
    Params P;
    __device__ __forceinline__ void operator()(const f32x4 (&acc)[2][2][4][2], const pg8::Unit& u, int wr, int wc, int fr, int fq) const {
        const int row0 = u.pm * 256 + wr * 64 + fr, col0 = u.pn * 256 + wc * 32 + 8 * fq;
        f32x4 bv[2][2];
#pragma unroll
        for (int bj = 0; bj < 2; ++bj)
#pragma unroll
            for (int n = 0; n < 2; ++n) bv[bj][n] = *(const f32x4*)(P.b_glu + col0 + bj * 128 + 4 * n);
#pragma unroll
        for (int ai = 0; ai < 2; ++ai)
#pragma unroll
            for (int m = 0; m < 4; ++m) { const size_t row = (size_t)(row0 + ai * 128 + m * 16);
#pragma unroll
                for (int bj = 0; bj < 2; ++bj) { const int col = col0 + bj * 128;
                    const h16x8 z = *(const h16x8*)(P.ZG + row * 512 + col), zs = *(const h16x8*)(P.ZS + row * PT + col);
                    f32x4 v0 = acc[ai][bj][m][0] + bv[bj][0], v1 = acc[ai][bj][m][1] + bv[bj][1];
#pragma unroll
                    for (int e = 0; e < 4; ++e) { v0[e] = (float)z[e] * sigmoid_f(v0[e]) * (float)zs[e]; v1[e] = (float)z[4 + e] * sigmoid_f(v1[e]) * (float)zs[4 + e]; }
                    *(u32x4*)(P.H + row * 1024 + col) = pack8(v0, v1); } }
    }
};
struct EpiOut {
    static constexpr bool PERM = false, AFTER_DRAIN = false;
    Params P;
    __device__ __forceinline__ void operator()(const f32x4 (&acc)[2][2][4][2], const pg8::Unit& u, int wr, int wc, int fr, int fq) const {
        const int row0 = u.pm * 256 + wr * 64 + fr, col0 = u.pn * 256 + wc * 32 + 4 * fq;
        const float* gate = P.mod + (size_t)(u.pm >> 3) * 3072 + 2048;
        f32x4 gv[2][2];
#pragma unroll
        for (int bj = 0; bj < 2; ++bj)
#pragma unroll
            for (int n = 0; n < 2; ++n) { const int cc = col0 + bj * 128 + n * 16;
                gv[bj][n] = *(const f32x4*)(P.b_ada + 2048 + cc) + ((*(const f32x4*)(gate + cc) + *(const f32x4*)(gate + 32 * 3072 + cc)) + (*(const f32x4*)(gate + 2 * 32 * 3072 + cc) + *(const f32x4*)(gate + 3 * 32 * 3072 + cc))); }
#pragma unroll
        for (int ai = 0; ai < 2; ++ai)
#pragma unroll
            for (int m = 0; m < 4; ++m) { const size_t off = (size_t)(row0 + ai * 128 + m * 16) * 1024 + col0;
#pragma unroll
                for (int bj = 0; bj < 2; ++bj)
#pragma unroll
                    for (int n = 0; n < 2; ++n) { const f32x4 xv = *(const f32x4*)(P.x + off + bj * 128 + n * 16);
                        *(f32x4*)(P.out + off + bj * 128 + n * 16) = xv + gv[bj][n] * acc[ai][bj][m][n]; } }
    }
};
namespace attn_body {
using bf16=unsigned short;
using bf16x8=__attribute__((ext_vector_type(8)))short;
using s16x4=__attribute__((ext_vector_type(4)))short;
using f32x16=__attribute__((ext_vector_type(16)))float;
using u32x4=__attribute__((ext_vector_type(4)))unsigned;
constexpr int BATCH=32,NHEAD=8,SEQ=2048,D=64,DM=520;
constexpr int NW=8,QBLK=32,QB=QBLK*NW,KVBLK=64,NQB=SEQ/QB;
constexpr int ATTN_PITCH=DM, ATTN_UNIT_ROWS=QB;
__device__ __forceinline__ int crow(int r,int hi){return (r&3)+8*(r>>2)+4*hi;}
#define SBAR() __builtin_amdgcn_sched_barrier(0)
constexpr int NSLOT=3, SLOTB=8192;
constexpr int LDS_K=0, LDS_V=NSLOT*SLOTB, LDS_WS=2*NSLOT*SLOTB, LDS_OST=LDS_WS+NW*64*4, LDS_TB=LDS_OST+NW*4096, TB_N=640, LDS_BYTES=LDS_TB+TB_N*4;
constexpr float C2=0.125f*1.4426950408889634f;
__device__ __forceinline__ void glds16s(const void*sbase,unsigned voff,unsigned lds_dst){unsigned keep;
  asm volatile("s_mov_b32 %0, m0\n\ts_mov_b32 m0, %3\n\ts_nop 2\n\tglobal_load_lds_dwordx4 %1, %2\n\ts_mov_b32 m0, %0":"=&s"(keep):"v"(voff),"s"(sbase),"s"(lds_dst):"memory");}
__device__ __forceinline__ void glds16(const void*gsrc,unsigned lds_dst){unsigned keep;
  asm volatile("s_mov_b32 %0, m0\n\ts_mov_b32 m0, %2\n\ts_nop 0\n\tglobal_load_lds_dwordx4 %1, off\n\ts_mov_b32 m0, %0":"=&s"(keep):"v"(gsrc),"s"(lds_dst):"memory");}
__device__ __forceinline__ float max3f(float a,float b,float c){float r;asm("v_max3_f32 %0, %1, %2, %3":"=v"(r):"v"(a),"v"(b),"v"(c));return r;}
__device__ __forceinline__ float max2f(float a,float b){float r;asm("v_max_f32_e32 %0, %1, %2":"=v"(r):"v"(a),"v"(b));return r;}
__device__ __forceinline__ float fadd_s(float a,float b){float r;asm("v_add_f32_e32 %0, %1, %2":"=v"(r):"v"(a),"v"(b));return r;}
__device__ __forceinline__ float fsub_s(float a,float b){float r;asm("v_sub_f32_e32 %0, %1, %2":"=v"(r):"v"(a),"v"(b));return r;}
typedef float f32x2_t __attribute__((ext_vector_type(2))); typedef _Float16 f16x2_t __attribute__((ext_vector_type(2))); typedef _Float16 f16x8_t __attribute__((ext_vector_type(8)));
#define MFMA16(a,b,c,x,y,z) __builtin_amdgcn_mfma_f32_32x32x16_f16(__builtin_bit_cast(f16x8_t,a),__builtin_bit_cast(f16x8_t,b),c,x,y,z)
__device__ __forceinline__ unsigned cvtpk_s(float lo,float hi){f32x2_t v={lo,hi};f16x2_t b=__builtin_convertvector(v,f16x2_t);return __builtin_bit_cast(unsigned,b);}
#define WAIT_BAR(N) asm volatile("s_waitcnt vmcnt(" #N ") lgkmcnt(0)\n\ts_barrier":::"memory")

__device__ __forceinline__ void qkt(f32x16&p0,f32x16&p1,const char*Kslot,const bf16x8*qr,const f32x16&negm,int r32,int hi){
  const char*kb=Kslot+hi*1024+r32*16;
  #pragma unroll
  for(int d0=0;d0<4;++d0){
    const bf16x8 b0=*reinterpret_cast<const bf16x8*>(kb+d0*2048);
    const bf16x8 b1=*reinterpret_cast<const bf16x8*>(kb+d0*2048+512);
    if(d0==0){p0=MFMA16(b0,qr[0],negm,0,0,0);p1=MFMA16(b1,qr[0],negm,0,0,0);}
    else{p0=MFMA16(b0,qr[d0],p0,0,0,0);p1=MFMA16(b1,qr[d0],p1,0,0,0);}}
}
typedef __attribute__((address_space(3))) const char* lds_cptr;
typedef short v4i16_t __attribute__((ext_vector_type(4)));
__device__ __forceinline__ void kload8(bf16x8*kf,lds_cptr kp){
  kf[0]=*(const __attribute__((address_space(3))) bf16x8*)(kp);      kf[1]=*(const __attribute__((address_space(3))) bf16x8*)(kp+512);
  kf[2]=*(const __attribute__((address_space(3))) bf16x8*)(kp+2048); kf[3]=*(const __attribute__((address_space(3))) bf16x8*)(kp+2560);
  kf[4]=*(const __attribute__((address_space(3))) bf16x8*)(kp+4096); kf[5]=*(const __attribute__((address_space(3))) bf16x8*)(kp+4608);
  kf[6]=*(const __attribute__((address_space(3))) bf16x8*)(kp+6144); kf[7]=*(const __attribute__((address_space(3))) bf16x8*)(kp+6656);
}
__device__ __forceinline__ void kload2(bf16x8*kf,lds_cptr kp,int j){ kf[2*j]=*(const __attribute__((address_space(3))) bf16x8*)(kp+j*2048); kf[2*j+1]=*(const __attribute__((address_space(3))) bf16x8*)(kp+j*2048+512); }
__device__ __forceinline__ s16x4 vtr(lds_cptr p){ return __builtin_bit_cast(s16x4,__builtin_amdgcn_ds_read_tr16_b64_v4i16((__attribute__((address_space(3))) v4i16_t*)p)); }
__device__ __forceinline__ float rowmax(const f32x16&p0,const f32x16&p1){
  float a=max3f(p0[0],p0[1],p1[0]),b=max3f(p0[2],p0[3],p1[1]);a=max3f(a,p1[2],p1[3]);
  #pragma unroll
  for(int r=4;r<16;r+=4){a=max3f(a,p0[r],p0[r+1]);b=max3f(b,p0[r+2],p0[r+3]);a=max3f(a,p1[r],p1[r+1]);b=max3f(b,p1[r+2],p1[r+3]);}
  const float m=max2f(a,b);
  auto rr=__builtin_amdgcn_permlane32_swap(__float_as_uint(m),__float_as_uint(m),false,false);
  return max2f(__uint_as_float(rr[0]),__uint_as_float(rr[1]));
}
__device__ __forceinline__ void pv(f32x16*o,int vb,bf16x8 pa0,bf16x8 pa1,bf16x8 pa2,bf16x8 pa3){
  #pragma unroll
  for(int d0=0;d0<2;++d0){s16x4 lo[4],hi[4];
    #pragma unroll
    for(int ks=0;ks<4;++ks){
      asm volatile("ds_read_b64_tr_b16 %0,%1 offset:%c2":"=&v"(lo[ks]):"v"(vb),"i"(d0*4096+ks*1024):"memory");
      asm volatile("ds_read_b64_tr_b16 %0,%1 offset:%c2":"=&v"(hi[ks]):"v"(vb),"i"(d0*4096+ks*1024+512):"memory");}
    asm volatile("s_waitcnt lgkmcnt(0)":::"memory");SBAR();
    #define PK(k) (bf16x8){lo[k][0],lo[k][1],lo[k][2],lo[k][3],hi[k][0],hi[k][1],hi[k][2],hi[k][3]}
    o[d0]=MFMA16(pa0,PK(0),o[d0],0,0,0);
    o[d0]=MFMA16(pa1,PK(1),o[d0],0,0,0);
    o[d0]=MFMA16(pa2,PK(2),o[d0],0,0,0);
    o[d0]=MFMA16(pa3,PK(3),o[d0],0,0,0);
    #undef PK
  }
}

#ifndef ATTN_STORE16
#define ATTN_STORE16(p,v) (*(u32x4*)(p)=(v))
#endif
typedef unsigned u32x2_t __attribute__((ext_vector_type(2)));
#define CINIT (f32x16{})
constexpr int OPITCH=1024;
template<int THRL,bool NOMASK=false> __device__ __forceinline__ void attn_unit(int b,int h,int qb,const bf16*Q,const bf16*__restrict__ K,const bf16*__restrict__ V,bf16*O,const bf16*__restrict__ ZA,const unsigned*__restrict__ MASK,char*shm){
  int tid_=threadIdx.x; asm volatile("":"+v"(tid_));
  const int tid=tid_,lane=tid&63,r32=lane&31,hi=lane>>5; const int wid=__builtin_amdgcn_readfirstlane(tid>>6);
  const long rowbase=(long)b*SEQ; const int q0=qb*QB;
  const bf16*Qw=Q+(rowbase+q0+wid*QBLK)*DM+h*D;
  const bf16*Kh=K+rowbase*DM+h*D,*Vh=V+rowbase*DM+h*D;
  const unsigned lds0=(unsigned)(uintptr_t)shm;
  float*wsf=(float*)(shm+LDS_WS)+wid*64;
  const bf16*ksrc=Kh+wid*8; const unsigned kvo=(unsigned)lane*(DM*2);
  const bf16*vsrc=Vh+(long)(16*(wid&3))*DM+(wid>>2)*32; const unsigned vvo=(unsigned)(lane>>2)*(DM*2)+(unsigned)(lane&3)*16;
  const unsigned kdst=lds0+LDS_K+wid*1024, vdst=lds0+LDS_V+wid*1024;
  #define DMA_K(t,slot) glds16s(ksrc+(long)(t)*KVBLK*DM,kvo,(unsigned)__builtin_amdgcn_readfirstlane(kdst+(slot)))
  #define DMA_V(t,slot) glds16s(vsrc+(long)(t)*KVBLK*DM,vvo,(unsigned)__builtin_amdgcn_readfirstlane(vdst+(slot)))
  const int vb0=(int)(lds0+LDS_V)+((lane>>4)&1)*32+(lane&3)*8+(4*hi+((lane&15)>>2))*64;
  const char*Kbase=shm+LDS_K; bf16x8 kf[8];
  const lds_cptr shm3=(lds_cptr)shm; const lds_cptr kp0=shm3+LDS_K+hi*1024+r32*16; const lds_cptr vp0=shm3+LDS_V+((lane>>4)&1)*32+(lane&3)*8+(4*hi+((lane&15)>>2))*64;
  const int NT=(q0+QB)/KVBLK;
  DMA_K(0,0);DMA_V(0,0);DMA_K(1,SLOTB);
  bf16x8 qr[4];
  #pragma unroll
  for(int d0=0;d0<4;++d0)qr[d0]=*reinterpret_cast<const bf16x8*>((const char*)Qw+((unsigned)r32*(DM*2)+(unsigned)hi*16+(unsigned)d0*32));
  float l_reg=0.f;f32x16 o[2];o[0]=f32x16{};o[1]=f32x16{};
  #define negm CINIT
  const int qabs=q0+wid*QBLK+r32; const char*mbase=(const char*)(MASK+(size_t)rowbase*64); const unsigned moff=(unsigned)qabs*256u;
  u32x2_t mwc=*(const u32x2_t*)(mbase+moff);
  #define MASKB(C0,C1,W) do{ if(NOMASK){asm volatile("":"+v"((W)));break;} const int w0_=(int)((W).x>>(4*hi)), w1_=(int)((W).y>>(4*hi)); \
    _Pragma("unroll") for(int r=0;r<16;++r){ const unsigned m0_=(unsigned)__builtin_amdgcn_sbfe(w0_,(r&3)+8*(r>>2),1), m1_=(unsigned)__builtin_amdgcn_sbfe(w1_,(r&3)+8*(r>>2),1); \
      C0[r]=__uint_as_float((__float_as_uint(C0[r])&m0_)|(0xFF800000u&~m0_)); C1[r]=__uint_as_float((__float_as_uint(C1[r])&m1_)|(0xFF800000u&~m1_)); if((r&3)==3)SBAR(); } }while(0)
  #define BIAS(C0,C1,t) do{ if((t)>=NT-6 && 64*(t)+176>q0+wid*QBLK){     int lb_=lane; asm volatile("":"+v"(lb_)); const __attribute__((address_space(3))) float* tp_=(const __attribute__((address_space(3))) float*)((lds_cptr)shm+LDS_TB)+(64*(t)+4*(lb_>>5)-(q0+wid*QBLK+(lb_&31))+383); \
    _Pragma("unroll") for(int r=0;r<16;++r){ C0[r]+=tp_[(r&3)+8*(r>>2)]; C1[r]+=tp_[32+(r&3)+8*(r>>2)]; } } }while(0)
  #define START(P0,P1) do{ \
    MASKB(P0,P1,mwc); \
    _Pragma("unroll") for(int r=0;r<16;++r)P0[r]=__builtin_amdgcn_exp2f(P0[r]); }while(0)
  #define RESC() do{}while(0)
  f32x16 pA0,pA1,pB0,pB1;
  int sl_prev=0,sl_cur=0,sl_next=SLOTB;
  #define ROT() do{sl_prev=sl_cur;sl_cur=sl_next;sl_next=(sl_next==(NSLOT-1)*SLOTB)?0:sl_next+SLOTB;}while(0)
  DMA_K(2,2*SLOTB);
  WAIT_BAR(3);
  qkt(pA0,pA1,Kbase,qr,negm,r32,hi);asm volatile("s_nop 15\n\ts_nop 7":"+v"(pA0),"+v"(pA1));BIAS(pA0,pA1,0);
  START(pA0,pA1);
  _Pragma("unroll") for(int r=0;r<16;++r)pA1[r]=__builtin_amdgcn_exp2f(pA1[r]);
  mwc=*(const u32x2_t*)(mbase+(moff+8u));
  WAIT_BAR(0);
  DMA_K(3,0);DMA_V(1,SLOTB);
  ROT();
  kload8(kf,kp0+sl_cur);
  WAIT_BAR(2);
  s16x4 vlo[8],vhi[8]; u32x4 pw0,pw1,pw2,pw3;
  #define PKW(P,B) cvtpk_s(P[B],P[B+1])
  #define PAF(k) __builtin_bit_cast(bf16x8,pw##k)
  #define VFR(i) (bf16x8){vlo[i][0],vlo[i][1],vlo[i][2],vlo[i][3],vhi[i][0],vhi[i][1],vhi[i][2],vhi[i][3]}
  #define PIN(x) asm volatile("":"+v"(x))
  #define MX3(a,b,c) __builtin_fmaxf(__builtin_fmaxf((a),(b)),(c))
  #define GAPA(MF,A0,A1,A2,A3,W0,W1,PW) do{ MF; sacc+=A0; sacc+=A1; sacc+=A2; sacc+=A3; PIN(sacc); W0; W1; PIN(PW); SBAR(); }while(0)
  #define EX(v) __builtin_amdgcn_exp2f(v)
  #define GAPB(MF,X,B) do{ MF; X[B]=EX(X[B]); X[B+1]=EX(X[B+1]); X[B+2]=EX(X[B+2]); X[B+3]=EX(X[B+3]); PIN(X); SBAR(); }while(0)
  #define VRD(i) do{ vlo[i]=vtr(vp_+(((i)>>2)*4096+((i)&3)*1024)); vhi[i]=vtr(vp_+(((i)>>2)*4096+((i)&3)*1024+512)); }while(0)
  #define KRD(G,j) do{ if(G){ kload2(kf,kp0+sl_next,j); SBAR(); } }while(0)
  #define STEP(C0,C1,P0,P1,t,GK,GV,GL) STEPM(C0,C1,P0,P1,t,GK,GV,GL,GV)
  #define STEPM(C0,C1,P0,P1,t,GK,GV,GL,GM) do{ SBAR(); \
    const lds_cptr vp_=vp0+sl_prev; \
    VRD(0); SBAR(); float sacc=(P0[0]+P0[1]); \
    GAPA(C0=MFMA16(kf[0],qr[0],negm,0,0,0), P0[2],P0[3],P0[4],P0[5],     pw0[0]=PKW(P0,0), pw0[1]=PKW(P0,2), pw0); \
    VRD(4); SBAR(); GAPA(C1=MFMA16(kf[1],qr[0],negm,0,0,0), P0[6],P0[7],P0[8],P0[9],     pw0[2]=PKW(P0,4), pw0[3]=PKW(P0,6), pw0); \
    VRD(1); SBAR(); GAPA(C0=MFMA16(kf[2],qr[1],C0,0,0,0),   P0[10],P0[11],P0[12],P0[13], pw1[0]=PKW(P0,8), pw1[1]=PKW(P0,10), pw1); \
    VRD(5); SBAR(); GAPA(C1=MFMA16(kf[3],qr[1],C1,0,0,0),   P0[14],P0[15],P1[0],P1[1],   pw1[2]=PKW(P0,12),pw1[3]=PKW(P0,14), pw1); \
    VRD(2); SBAR(); GAPA(C0=MFMA16(kf[4],qr[2],C0,0,0,0),   P1[2],P1[3],P1[4],P1[5],     pw2[0]=PKW(P1,0), pw2[1]=PKW(P1,2), pw2); \
    VRD(6); SBAR(); GAPA(C1=MFMA16(kf[5],qr[2],C1,0,0,0),   P1[6],P1[7],P1[8],P1[9],     pw2[2]=PKW(P1,4), pw2[3]=PKW(P1,6), pw2); \
    VRD(3); SBAR(); GAPA(C0=MFMA16(kf[6],qr[3],C0,0,0,0),   P1[10],P1[11],P1[12],P1[13], pw3[0]=PKW(P1,8), pw3[1]=PKW(P1,10), pw3); \
    VRD(7); SBAR(); GAPA(C1=MFMA16(kf[7],qr[3],C1,0,0,0),   P1[14],P1[15],0.f,0.f,       pw3[2]=PKW(P1,12),pw3[3]=PKW(P1,14), pw3); \
    l_reg+=sacc; \
    BIASX(C0,C1,t); \
    MASKB(C0,C1,mwc); \
    if(GM){mwc=*(const u32x2_t*)(mbase+(moff+8u*(unsigned)((t)+1)));} \
    if(GK){DMA_K((t)+3,sl_cur);} if(GV){DMA_V((t)+1,sl_next);} \
    SBAR(); \
    GAPB(o[0]=MFMA16(PAF(0),VFR(0),o[0],0,0,0), C0,0); \
    GAPB(o[1]=MFMA16(PAF(0),VFR(4),o[1],0,0,0), C0,4); \
    KRD(GL,0); GAPB(o[0]=MFMA16(PAF(1),VFR(1),o[0],0,0,0), C0,8); \
    KRD(GL,1); GAPB(o[1]=MFMA16(PAF(1),VFR(5),o[1],0,0,0), C0,12); \
    KRD(GL,2); GAPB(o[0]=MFMA16(PAF(2),VFR(2),o[0],0,0,0), C1,0); \
    KRD(GL,3); GAPB(o[1]=MFMA16(PAF(2),VFR(6),o[1],0,0,0), C1,4); \
    GAPB(o[0]=MFMA16(PAF(3),VFR(3),o[0],0,0,0), C1,8); \
    GAPB(o[1]=MFMA16(PAF(3),VFR(7),o[1],0,0,0), C1,12); \
    }while(0)
  int t=1;
  #define BIASX(P0,P1,t) do{}while(0)
  for(;t+7<NT;t+=2){
    STEP(pB0,pB1,pA0,pA1,t,true,true,true);     WAIT_BAR(2); RESC(); ROT();
    STEP(pA0,pA1,pB0,pB1,t+1,true,true,true);   WAIT_BAR(2); RESC(); ROT();
  }
  #undef BIASX
  #define BIASX(P0,P1,t) BIAS(P0,P1,t)
  #define ENDW(tt) do{ if((tt)+3<NT){WAIT_BAR(2);} else if((tt)+2<NT){WAIT_BAR(1);} else {WAIT_BAR(0);} }while(0)
  for(;t+3<NT;t+=2){
    STEP(pB0,pB1,pA0,pA1,t,true,true,true);     WAIT_BAR(2); RESC(); ROT();
    STEP(pA0,pA1,pB0,pB1,t+1,true,true,true);   WAIT_BAR(2); RESC(); ROT();
  }
  #define FIN(P0,P1,VSL) do{ float sacc=P0[0]+P0[1]; _Pragma("unroll") for(int r=2;r<16;++r)sacc+=P0[r]; _Pragma("unroll") for(int r=0;r<16;++r)sacc+=P1[r]; l_reg+=sacc; \
    pw0=(u32x4){PKW(P0,0),PKW(P0,2),PKW(P0,4),PKW(P0,6)};pw1=(u32x4){PKW(P0,8),PKW(P0,10),PKW(P0,12),PKW(P0,14)};pw2=(u32x4){PKW(P1,0),PKW(P1,2),PKW(P1,4),PKW(P1,6)};pw3=(u32x4){PKW(P1,8),PKW(P1,10),PKW(P1,12),PKW(P1,14)}; \
    SBAR(); pv(o,vb0+(VSL),PAF(0),PAF(1),PAF(2),PAF(3)); }while(0)
  STEP(pB0,pB1,pA0,pA1,t,false,true,true);        WAIT_BAR(1); RESC(); ROT();
  if(wid>=4){
    STEP(pA0,pA1,pB0,pB1,t+1,false,true,true);    WAIT_BAR(0); RESC(); ROT();
    STEP(pB0,pB1,pA0,pA1,NT-1,false,false,false); RESC();
    FIN(pB0,pB1,sl_cur);
  } else {
    FIN(pB0,pB1,sl_prev); DMA_V(t+2,sl_next);     WAIT_BAR(0); ROT();
  }
  #undef FIN
  #undef PKW
  #undef PAF
  #undef VFR
  #undef PIN
  #undef MX3
  #undef GAPA
  #undef GAPB
  #undef EX
  #undef VRD
  #undef KRD
  #undef STEP
  #undef STEPM
  #undef ENDW
  {auto rr=__builtin_amdgcn_permlane32_swap(__float_as_uint(l_reg),__float_as_uint(l_reg),false,false);l_reg=__uint_as_float(rr[0])+__uint_as_float(rr[1]);}
  int lane_e; asm volatile("v_mbcnt_lo_u32_b32 %0, -1, 0\n\tv_mbcnt_hi_u32_b32 %0, -1, %0":"=v"(lane_e)); const int r32e=lane_e&31, hie=lane_e>>5;
  if(hie==0)wsf[32+r32e]=l_reg;asm volatile("s_waitcnt lgkmcnt(0)":::"memory");
  float rli[16];
  #pragma unroll
  for(int r=0;r<16;++r)rli[r]=__builtin_amdgcn_rcpf(wsf[32+crow(r,hie)]);
  bf16*Ow=O+(rowbase+q0+wid*QBLK)*OPITCH+h*D; const bf16*Zw=ZA+(rowbase+q0+wid*QBLK)*DM+h*D;
  { bf16*stg=(bf16*)(shm+LDS_OST)+wid*2048;
    #pragma unroll
    for(int r=0;r<16;++r){const int orow=crow(r,hie);
      #pragma unroll
      for(int d0=0;d0<2;++d0)stg[orow*64+d0*32+r32e]=__builtin_bit_cast(unsigned short,(_Float16)(o[d0][r]*rli[r]));}
    asm volatile("s_waitcnt lgkmcnt(0)":::"memory");
    int le_=lane_e; asm volatile("":"+v"(le_));
    #pragma unroll
    for(int i=0;i<4;++i){const int row=i*8+(le_>>3),ch=le_&7; const f16x8_t v=*(const f16x8_t*)(stg+row*64+ch*8), z=*(const f16x8_t*)((const char*)Zw+((unsigned)row*(DM*2)+(unsigned)ch*16)); const f16x8_t g=v*z; ATTN_STORE16((char*)Ow+((unsigned)row*(OPITCH*2)+(unsigned)ch*16),__builtin_bit_cast(u32x4,g));} }
  asm volatile("s_waitcnt lgkmcnt(0)\n\ts_barrier":::"memory");
  #undef DMA_K
  #undef DMA_V
  #undef BIASX
  #undef BIAS
  #undef MASKB
  #undef START
  #undef negm
  #undef RESC
  #undef ROT
}
constexpr int ATTN_LDS_BYTES=LDS_BYTES;
struct AttnTensors { const bf16* Q; const bf16* K; const bf16* V; bf16* O; const bf16* ZA; const unsigned* MASK; };
struct AttnUnit { int bh; int qb; };
struct StaticOrder {
  int vcu, G;
  __device__ __forceinline__ explicit StaticOrder(int grid,int block):vcu((grid%8==0)?(block%8)*(grid/8)+block/8:block),G(grid){}
  __device__ __forceinline__ bool next(int i,AttnUnit&u)const{ u.bh=vcu+(i>>3)*G; u.qb=7-(i&7); return u.bh<BATCH*NHEAD; }
  __device__ __forceinline__ void a_ready(const AttnUnit&)const{}
  __device__ __forceinline__ void done(const AttnUnit&)const{}
};
__device__ __forceinline__ int t5b(int d){ if(d<16)return d; int b=16; b+=(d>=19);b+=(d>=21);b+=(d>=24);b+=(d>=27);b+=(d>=31);b+=(d>=35);b+=(d>=40);b+=(d>=46);b+=(d>=52);b+=(d>=59);b+=(d>=67);b+=(d>=77);b+=(d>=87);b+=(d>=99);b+=(d>=113); return b; }
template<class Sched,int THRL=8,bool NOMASK=false> __device__ __forceinline__ void attn_phase(char*lds,const AttnTensors&T,const float*rel_bias,const Sched&S){
  AttnUnit u; int hcur=-1;
  for(int i=0;S.next(i,u);++i){
    const int h=u.bh%NHEAD;
    if(h!=hcur){ hcur=h; __attribute__((address_space(3))) float* tb=(__attribute__((address_space(3))) float*)((lds_cptr)lds+LDS_TB);
      int tj_=threadIdx.x; asm volatile("":"+v"(tj_));
      for(int j=tj_;j<TB_N;j+=NW*64){ const int d=383-j; tb[j]=(d<0)?0.f:(rel_bias[t5b(d)*NHEAD+h]-rel_bias[31*NHEAD+h])*1.4426950408889634f; }
      __syncthreads(); }
    S.a_ready(u); attn_unit<THRL,NOMASK>(u.bh/NHEAD,h,u.qb,T.Q,T.K,T.V,T.O,T.ZA,T.MASK,lds); S.done(u); }
}
#undef SBAR
#undef WAIT_BAR
}
__device__ __forceinline__ void p0_mod_unit(const Params& P, LAS unsigned char* lds, int unit) {
    const int tid = threadIdx.x, wave = tid >> 6, lane = tid & 63, cg = unit % 48, kq = unit / 48;
    LAS float* cond = (LAS float*)lds;
    for (int i = tid; i < 32 * 256; i += 512) { const int b = i & 31, k = i >> 5; const float cv = P.c[b * 1024 + kq * 256 + k]; cond[i] = cv / (1.f + expf(-cv)); }
    __syncthreads();
    float acc[32];
#pragma unroll
    for (int b = 0; b < 32; ++b) acc[b] = 0.f;
    const float* w = P.w_ada + (size_t)(kq * 256 + wave * 32) * 3072 + cg * 64 + lane;
#pragma unroll 4
    for (int k = 0; k < 32; ++k) {
        const float wv = w[(size_t)k * 3072];
        const LAS f32x4* cp = (const LAS f32x4*)(cond + (wave * 32 + k) * 32);
#pragma unroll
        for (int j = 0; j < 8; ++j) { const f32x4 c4 = cp[j]; acc[4 * j] += c4[0] * wv; acc[4 * j + 1] += c4[1] * wv; acc[4 * j + 2] += c4[2] * wv; acc[4 * j + 3] += c4[3] * wv; }
    }
    __syncthreads();
    LAS float* part = (LAS float*)lds;
#pragma unroll
    for (int b = 0; b < 32; ++b) part[(wave * 32 + b) * 64 + lane] = acc[b];
    __syncthreads();
    for (int o = tid; o < 2048; o += 512) { const int b = o >> 6, cl = o & 63; float s = 0.f;
#pragma unroll
        for (int wv = 0; wv < 8; ++wv) s += part[(wv * 32 + b) * 64 + cl];
        P.mod[(size_t)(kq * 32 + b) * 3072 + cg * 64 + cl] = s; }
    __syncthreads();
}
__device__ __forceinline__ void transpose_item(const float* W, int K, int N, u16* WT, int n0, int prow0, int k0, LAS float* scr, int lane) {
    const int n = n0 + (lane & 31); const bool ok = n < N;
#pragma unroll 8
    for (int i = 0; i < 32; ++i) { const int kk = 2 * i + (lane >> 5); scr[kk * 33 + (lane & 31)] = ok ? W[(size_t)(k0 + kk) * N + n] : 0.f; }
    LDS_WAIT();
    const int c = lane & 7;
#pragma unroll
    for (int j = 0; j < 4; ++j) { const int nn = (lane >> 3) + 8 * j; const LAS float* s = scr + (8 * c) * 33 + nn;
        u32x4 o; o.x = pkh(s[0], s[33]); o.y = pkh(s[2 * 33], s[3 * 33]); o.z = pkh(s[4 * 33], s[5 * 33]); o.w = pkh(s[6 * 33], s[7 * 33]);
        *(u32x4*)(WT + (size_t)(prow0 + nn) * K + k0 + 8 * c) = o; }
    LDS_WAIT();
}
__device__ __forceinline__ void p0_prologue(const Params& P, LAS unsigned char* lds) {
    const int tid = threadIdx.x, wave = tid >> 6, lane = tid & 63, G = gridDim.x;
#if MK_COOP
    if (blockIdx.x == 0) for (int i = tid; i < CTL_WORDS; i += 512) P.ctl[i] = 0u;
#endif
    for (int unit = blockIdx.x; unit < 192; unit += G) p0_mod_unit(P, lds, unit);
    LAS float* scr = (LAS float*)(lds + wave * 8448);
    const int gw = blockIdx.x * 8 + wave, NGW = G * 8;
    constexpr int I_IN = 16 * 120, I_OUT = 16 * 32, I_GLU = 8 * 16;
    for (int it = gw; it < I_IN + I_OUT + I_GLU; it += NGW) {
        int r = it;
        if (r < I_IN) { const int kb = r / 120, nb = r % 120, pn = nb >> 3, bj = (nb >> 2) & 1, wc = nb & 3;
            transpose_item(P.w_in, 1024, NIN, P.win_t, 256 * pn + 64 * wc + 32 * bj, 32 * nb, 64 * kb, scr, lane); continue; }
        r -= I_IN;
        if (r < I_OUT) { const int kb = r / 32, nb = r % 32; transpose_item(P.w_out, 1024, 1024, P.wout_t, 32 * nb, 32 * nb, 64 * kb, scr, lane); continue; }
        r -= I_OUT;
        { const int kb = r / 16, nb = r % 16; transpose_item(P.w_glu, 512, 512, P.wglu_t, 32 * nb, 32 * nb, 64 * kb, scr, lane); }
    }
    const int nb0 = G >= 200 ? 192 : 0;
    for (int i = ((int)blockIdx.x - nb0) * 512 + tid; i >= 0 && i < 2048; i += G * 512) {
        const int g = i >> 6;
        const double dt = exp((double)P.log_dt[g]), ar = P.a_re[i], ai = P.a_im[i];
        const double e = exp(ar * dt); double sn, cs; sincos(ai * dt, &sn, &cs);
        const double lr = e * cs, li = e * sn;
        const double nr = lr - 1.0, ni = li, den = ar * ar + ai * ai;
        const double cr = (nr * ar + ni * ai) / den, ci = (ni * ar - nr * ai) / den;
        P.LB[i] = (f32x2){(float)lr, (float)li};
        const int p = i & 63; const double idt = 1.0 / dt;
        if (p == 0) P.DT[g] = (float)dt;
        for (int c = 0; c < 16; ++c) { P.CCh[(size_t)(g * 16 + c) * 128 + 2 * p] = __builtin_bit_cast(u16, (h16)P.c_re[(g * 16 + c) * 64 + p]); P.CCh[(size_t)(g * 16 + c) * 128 + 2 * p + 1] = __builtin_bit_cast(u16, (h16)(-P.c_im[(g * 16 + c) * 64 + p])); }
        for (int c = 0; c < 16; ++c) { const double br = P.b_re[i * 16 + c], bi = P.b_im[i * 16 + c]; const double rr = cr * br - ci * bi, ii = cr * bi + ci * br; P.BB[i * 16 + c] = (f32x2){(float)rr, (float)ii};
            P.BBh[(size_t)(g * 128 + 2 * p) * 16 + c] = __builtin_bit_cast(u16, (h16)(float)(rr * idt)); P.BBh[(size_t)(g * 128 + 2 * p + 1) * 16 + c] = __builtin_bit_cast(u16, (h16)(float)(ii * idt)); }
    }
}
__device__ __forceinline__ void p1_norm(const Params& P) {
    const int tid = threadIdx.x, wave = tid >> 6, lane = tid & 63;
    const int gw = blockIdx.x * 8 + wave, NGW = gridDim.x * 8;
    for (int ch = gw; ch < MT / 32; ch += NGW) {
        const int row0 = ch * 32;
        const float* md = P.mod + (size_t)(row0 >> 11) * 3072;
        f32x4 gs[2][2], sh[2][2];
#pragma unroll
        for (int j = 0; j < 2; ++j)
#pragma unroll
            for (int k = 0; k < 2; ++k) { const int cc = 8 * lane + 512 * j + 4 * k;
                const f32x4 s_sh = *(const f32x4*)(P.b_ada + cc) + ((*(const f32x4*)(md + cc) + *(const f32x4*)(md + 32 * 3072 + cc)) + (*(const f32x4*)(md + 2 * 32 * 3072 + cc) + *(const f32x4*)(md + 3 * 32 * 3072 + cc)));
                const f32x4 s_sc = *(const f32x4*)(P.b_ada + 1024 + cc) + ((*(const f32x4*)(md + 1024 + cc) + *(const f32x4*)(md + 32 * 3072 + 1024 + cc)) + (*(const f32x4*)(md + 2 * 32 * 3072 + 1024 + cc) + *(const f32x4*)(md + 3 * 32 * 3072 + 1024 + cc)));
                sh[j][k] = s_sh; gs[j][k] = *(const f32x4*)(P.norm_g + cc) * (s_sc + 1.0f); }
        for (int i = 0; i < 32; i += 4) {
            const int row = row0 + i;
            f32x4 v[4][2][2]; float ss[4] = {0.f, 0.f, 0.f, 0.f};
#pragma unroll
            for (int r = 0; r < 4; ++r)
#pragma unroll
                for (int j = 0; j < 2; ++j)
#pragma unroll
                    for (int k = 0; k < 2; ++k) v[r][j][k] = __builtin_nontemporal_load((const f32x4*)(P.x + (size_t)(row + r) * 1024 + 8 * lane + 512 * j + 4 * k));
#pragma unroll
            for (int r = 0; r < 4; ++r)
#pragma unroll
                for (int j = 0; j < 2; ++j)
#pragma unroll
                    for (int k = 0; k < 2; ++k) ss[r] += (v[r][j][k][0] * v[r][j][k][0] + v[r][j][k][1] * v[r][j][k][1]) + (v[r][j][k][2] * v[r][j][k][2] + v[r][j][k][3] * v[r][j][k][3]);
#pragma unroll
            for (int r = 0; r < 4; ++r) ss[r] = wave_sum_f(ss[r]);
#pragma unroll
            for (int r = 0; r < 4; ++r) { const float rs = 1.0f / sqrtf(ss[r] * (1.0f / 1024.0f) + RMS_EPS);
#pragma unroll
                for (int j = 0; j < 2; ++j) { const f32x4 h0 = (v[r][j][0] * rs) * gs[j][0] + sh[j][0], h1 = (v[r][j][1] * rs) * gs[j][1] + sh[j][1];
                    *(u32x4*)(P.H + (size_t)(row + r) * 1024 + 8 * lane + 512 * j) = pack8(h0, h1); } }
        }
    }
}
constexpr int SROW = 528;
__device__ __forceinline__ void ssm_pair(const Params& P, LAS unsigned char* wl, int b, int g) {
    const int lane = threadIdx.x & 63, r32 = lane & 31, hi = lane >> 5, l15 = lane & 15, kq = lane >> 4;
    h16x8 bbf[4], ccf[4];
#pragma unroll
    for (int nt = 0; nt < 4; ++nt) bbf[nt] = *(const h16x8*)(P.BBh + (size_t)(g * 128 + 32 * nt + r32) * 16 + 8 * hi);
#pragma unroll
    for (int ks = 0; ks < 4; ++ks) ccf[ks] = *(const h16x8*)(P.CCh + (size_t)(g * 16 + l15) * 128 + 32 * ks + 8 * kq);
    const f32x2 lb = P.LB[g * 64 + lane];
    const float dt = P.DT[g];
    const f32x4 dsk = *(const f32x4*)(P.d_skip + 16 * g + 4 * kq);
    float hr = 0.f, hm = 0.f;
    const u16* ub = P.U + (size_t)b * SEQ * PT + 16 * g;
    u16* zb = P.ZG + (size_t)b * SEQ * 512 + 16 * g;
    h16x8 uf = *(const h16x8*)(ub + (size_t)r32 * PT + 8 * hi);
    for (int t0 = 0; t0 < SEQ; t0 += 32) {
        h16x8 un = uf;
        if (t0 + 32 < SEQ) un = *(const h16x8*)(ub + (size_t)(t0 + 32 + r32) * PT + 8 * hi);
#pragma unroll
        for (int nt = 0; nt < 4; ++nt) {
            const f32x16 s = __builtin_amdgcn_mfma_f32_32x32x16_f16(bbf[nt], uf, (f32x16){0.f, 0.f, 0.f, 0.f, 0.f, 0.f, 0.f, 0.f, 0.f, 0.f, 0.f, 0.f, 0.f, 0.f, 0.f, 0.f}, 0, 0, 0);
#pragma unroll
            for (int rq = 0; rq < 4; ++rq) *(LAS f32x4*)(wl + r32 * SROW + (32 * nt + 8 * rq + 4 * hi) * 4) = (f32x4){s[4 * rq], s[4 * rq + 1], s[4 * rq + 2], s[4 * rq + 3]};
        }
        LDS_WAIT();
#pragma unroll
        for (int tb = 0; tb < 4; ++tb) {
            f32x2 sv[8];
#pragma unroll
            for (int k = 0; k < 8; ++k) sv[k] = *(const LAS f32x2*)(wl + (8 * tb + k) * SROW + 8 * lane);
#pragma unroll
            for (int k = 0; k < 8; ++k) { const float nr = fmaf(lb[0], hr, fmaf(-lb[1], hm, sv[k][0])), ni = fmaf(lb[0], hm, fmaf(lb[1], hr, sv[k][1])); hr = nr; hm = ni;
                *(LAS unsigned*)(wl + (8 * tb + k) * SROW + 4 * lane) = pkh(hr, hm); }
        }
        LDS_WAIT();
#pragma unroll
        for (int mt = 0; mt < 2; ++mt) {
            f32x4 acc = {0.f, 0.f, 0.f, 0.f};
#pragma unroll
            for (int ks = 0; ks < 4; ++ks) { const h16x8 hf = *(const LAS h16x8*)(wl + (16 * mt + l15) * SROW + ks * 64 + kq * 16); acc = __builtin_amdgcn_mfma_f32_16x16x32_f16(ccf[ks], hf, acc, 0, 0, 0); }
            const size_t off = (size_t)(t0 + 16 * mt + l15) * 512 + 4 * kq;
            const h16x4 u4 = *(const h16x4*)(ub + (size_t)(t0 + 16 * mt + l15) * PT + 4 * kq);
            u32x2 w; w.x = pkh(gelu_fast_f(fmaf(acc[0], dt, dsk[0] * (float)u4[0])), gelu_fast_f(fmaf(acc[1], dt, dsk[1] * (float)u4[1])));
            w.y = pkh(gelu_fast_f(fmaf(acc[2], dt, dsk[2] * (float)u4[2])), gelu_fast_f(fmaf(acc[3], dt, dsk[3] * (float)u4[3])));
            *(u32x2*)(zb + off) = w;
        }
        LDS_WAIT();
        uf = un;
    }
}
constexpr int SC_STRIDE = 2052;
struct SelQ { unsigned lo, hi, T; int clo, chi, lastc, state; float lastT, mag, rdens; };
template <int NJ> __device__ __forceinline__ void sel_load(const LAS float* row, int q, int lane, float (&v)[4 * NJ], SelQ& S) {
    float s1 = 0.f, s2 = 0.f;
#pragma unroll
    for (int j = 0; j < NJ; ++j) { const int kb = 256 * j + 4 * lane; const f32x4 x = *(const LAS f32x4*)(row + kb);
#pragma unroll
        for (int e = 0; e < 4; ++e) {
            if (j >= NJ - 2) { const bool ok = (kb + e) <= q; v[4 * j + e] = ok ? x[e] : -INFINITY; const float y = ok ? x[e] : 0.f; s1 += y; s2 = fmaf(y, y, s2); }
            else { v[4 * j + e] = x[e]; s1 += x[e]; s2 = fmaf(x[e], x[e], s2); } } }
    s1 = wave_total_f(s1); s2 = wave_total_f(s2);
    const float n = (float)(q + 1), rn = __builtin_amdgcn_rcpf(n), mean = s1 * rn, var = fmaxf(s2 * rn - mean * mean, 1e-30f), rsd = __builtin_amdgcn_rsqf(var), sd = var * rsd;
    const float z = __builtin_amdgcn_logf((n - 256.f) * (1.f / 256.f)) * (0.6931471806f * 0.5875440658f);
    S.rdens = sd * __builtin_amdgcn_rcpf(n * __builtin_amdgcn_exp2f(-0.7213475204f * z * z) * 0.3989422804f);
    S.lo = 0x007FFFFFu; S.hi = 0xFF800000u; S.clo = q + 1; S.chi = 0; S.T = 0u; S.state = 0; S.lastT = mean + z * sd; S.mag = 0.f; S.lastc = 256;
}
__device__ __forceinline__ float sel_probe(SelQ& S, int it, unsigned& cand) {
    if (S.state == 0 && S.hi - S.lo <= 1u) { S.state = 2; S.T = S.lo; }
    if (S.state != 0) { cand = 0u; return INFINITY; }
    const bool lofin = S.lo != 0x007FFFFFu, hifin = S.hi != 0xFF800000u;
    if (lofin && hifin) {
        if (it >= 60) cand = S.lo + ((S.hi - S.lo) >> 1);
        else { const float flo = key2f(S.lo), fhi = key2f(S.hi);
            const float fr = (it % 3 == 2) ? 0.5f : fminf(fmaxf(((float)(S.clo - 256) + 0.5f) * __builtin_amdgcn_rcpf((float)(S.clo - S.chi)), 0.15f), 0.85f);
            cand = f2key(flo + (fhi - flo) * fr); }
    } else {
        if (it > 0) { S.mag = (S.mag == 0.f) ? 1.3f * fabsf((float)(S.lastc - 256)) * S.rdens + 1e-6f * (1.f + fabsf(S.lastT)) : S.mag * 2.f; if (!(S.mag < 1e30f)) S.mag = 1.f; S.lastT += (S.lastc > 256) ? S.mag : -S.mag; }
        cand = f2key(S.lastT);
    }
    cand = cand <= S.lo ? S.lo + 1u : cand; cand = cand >= S.hi ? S.hi - 1u : cand;
    return key2f(cand);
}
__device__ __forceinline__ void sel_update(SelQ& S, unsigned cand, float tf, int c) {
    if (S.state != 0) return;
    if (c == 256) { S.T = cand; S.state = 1; return; }
    if (c > 256) { S.lo = cand; S.clo = c; } else { S.hi = cand; S.chi = c; }
    S.lastT = tf; S.lastc = c;
}
template <int NJ> __device__ __forceinline__ void sel_finish(const float (&v)[4 * NJ], const SelQ& S, int lane, unsigned* mw, unsigned b0, unsigned b1) {
    const float Tf = key2f(S.T); const bool exact = S.state == 1;
    int idxcut = 4095;
    if (!exact) {
        int cgt = 0, ceq = 0;
#pragma unroll
        for (int r = 0; r < 4 * NJ; ++r) { cgt += (v[r] > Tf) ? 1 : 0; ceq += (v[r] == Tf) ? 1 : 0; }
        cgt = wave_total_i(cgt); ceq = wave_total_i(ceq);
        const int need = 256 - cgt;
        if (ceq > need) {
            int lo2 = 0, hi2 = 2047;
            while (lo2 < hi2) { const int mid = (lo2 + hi2) >> 1; int c = 0;
#pragma unroll
                for (int r = 0; r < 4 * NJ; ++r) c += (v[r] == Tf && (256 * (r >> 2) + 4 * lane + (r & 3)) <= mid) ? 1 : 0;
                c = wave_total_i(c);
                if (c >= need) hi2 = mid; else lo2 = mid + 1; }
            idxcut = lo2;
        }
    }
#pragma unroll
    for (int j = 0; j < NJ; ++j) { unsigned nib = 0u;
        if (exact) {
            nib = (~((j & 1) ? b1 : b0) >> (4 * (NJ / 2 - 1 - (j >> 1)))) & 0xFu;
        } else {
#pragma unroll
            for (int e = 3; e >= 0; --e) nib = nib + nib + (((v[4 * j + e] > Tf) || (v[4 * j + e] == Tf && (256 * j + 4 * lane + e) <= idxcut)) ? 1u : 0u);
        }
        int w = (int)(nib << (4 * (lane & 7)));
        w |= __builtin_amdgcn_update_dpp(0, w, 0xB1, 0xF, 0xF, false);
        w |= __builtin_amdgcn_update_dpp(0, w, 0x4E, 0xF, 0xF, false);
        w |= __builtin_amdgcn_update_dpp(0, w, 0x141, 0xF, 0xF, false);
        if ((lane & 7) == 0) mw[8 * j + (lane >> 3)] = (unsigned)w; }
}
template <int NJ> __device__ __forceinline__ void sel_query(const LAS float* row, int q, int lane, unsigned* mw) {
    float va[4 * NJ]; SelQ A; unsigned a0 = 0u, a1 = 0u;
    sel_load<NJ>(row, q, lane, va, A);
#pragma unroll 1
    for (int it = 0; it < 100; ++it) {
        unsigned ca_; const float ta = sel_probe(A, it, ca_);
        if (A.state != 0) break;
        a0 = 0u; a1 = 0u;
#pragma unroll
        for (int j = 0; j < NJ; j += 2)
#pragma unroll
            for (int e = 3; e >= 0; --e) { a0 = __builtin_amdgcn_alignbit(a0, __float_as_uint(va[4 * j + e] - ta), 31); a1 = __builtin_amdgcn_alignbit(a1, __float_as_uint(va[4 * j + 4 + e] - ta), 31); }
        sel_update(A, ca_, ta, 256 * NJ - wave_total_i(__builtin_popcount(a0) + __builtin_popcount(a1)));
        if (A.state != 0) break;
    }
    sel_finish<NJ>(va, A, lane, mw, a0, a1);
}
__device__ __forceinline__ void idx_unit(const Params& P, LAS unsigned char* lds, int unit) {
    const int tid = threadIdx.x, lane = tid & 63, wave = __builtin_amdgcn_readfirstlane(tid >> 6);
    const int b = unit >> 7, qb = unit & 127, q0 = qb * 16;
    unsigned* MW = P.mask + (size_t)(b * SEQ + q0) * 64;
    if (q0 + 15 <= 255) {
        for (int i = tid; i < 16 * 64; i += 512) { const int ql = i >> 6, w = i & 63, q = q0 + ql, lo = 32 * w;
            MW[i] = (q >= lo + 31) ? 0xFFFFFFFFu : (q < lo ? 0u : ((2u << (q - lo)) - 1u)); }
        return;
    }
    LAS float* SC = (LAS float*)lds;
    if (tid < 2) *(LAS unsigned*)(lds + LDS_MISC + 16 + 4 * tid) = 0u;
    const int ql = lane & 15, g4 = lane >> 4;
    const size_t qrow = (size_t)(b * SEQ + q0 + ql);
    h16x8 bq[8][2];
#pragma unroll
    for (int h = 0; h < 8; ++h)
#pragma unroll
        for (int ks = 0; ks < 2; ++ks) bq[h][ks] = *(const h16x8*)(P.QI + qrow * PT + 64 * h + 32 * ks + 8 * g4);
    float wq[8];
#pragma unroll
    for (int h = 0; h < 8; ++h) wq[h] = P.WI[qrow * 8 + h] * (0.5f * 0.35355339059327373f);
    h16x8 qt[2];
#pragma unroll
    for (int ks = 0; ks < 2; ++ks) {
#pragma unroll
        for (int j = 0; j < 8; ++j) { float s = 0.f;
#pragma unroll
            for (int h = 0; h < 8; ++h) s = fmaf(wq[h], (float)bq[h][ks][j], s);
            qt[ks][j] = (h16)s; } }
    const int ntile = qb + 1;
    { const u16* kpb = P.KI + (size_t)(b * SEQ + ql) * 64 + 8 * g4;
    h16x8 n0 = {}, n1 = {};
    if (wave < ntile) { n0 = *(const h16x8*)(kpb + (size_t)wave * 1024); n1 = *(const h16x8*)(kpb + (size_t)wave * 1024 + 32); }
    for (int kt = wave; kt < ntile; kt += 8) {
        const int key0 = kt * 16;
        const h16x8 a0 = n0, a1 = n1;
        if (kt + 8 < ntile) { n0 = *(const h16x8*)(kpb + (size_t)(kt + 8) * 1024); n1 = *(const h16x8*)(kpb + (size_t)(kt + 8) * 1024 + 32); }
        f32x4 sc = __builtin_amdgcn_mfma_f32_16x16x32_f16(a0, qt[0], (f32x4){0.f, 0.f, 0.f, 0.f}, 0, 0, 0);
        sc = __builtin_amdgcn_mfma_f32_16x16x32_f16(a1, qt[1], sc, 0, 0, 0);
#pragma unroll
        for (int h = 0; h < 8; ++h) { f32x4 r = __builtin_amdgcn_mfma_f32_16x16x32_f16(a0, bq[h][0], (f32x4){0.f, 0.f, 0.f, 0.f}, 0, 0, 0);
            r = __builtin_amdgcn_mfma_f32_16x16x32_f16(a1, bq[h][1], r, 0, 0, 0);
#pragma unroll
            for (int j = 0; j < 4; ++j) sc[j] = fmaf(__builtin_fabsf(r[j]), wq[h], sc[j]); }
        *(LAS f32x4*)(SC + ql * SC_STRIDE + key0 + 4 * g4) = sc;
    } }
    __syncthreads();
    constexpr int rq_ = 0;
    for (;;) {
        int qt = 0;
        if (lane == 0) qt = (int)__hip_atomic_fetch_add((LAS unsigned*)(lds + LDS_MISC + 16 + 4 * rq_), 1u, __ATOMIC_RELAXED, __HIP_MEMORY_SCOPE_WORKGROUP);
        qt = __builtin_amdgcn_readfirstlane(qt);
        if (qt >= 16) break;
        const LAS float* row = SC + qt * SC_STRIDE; unsigned* mw = MW + qt * 64; const int q = q0 + qt;
        switch (qb >> 5) {
            case 0: sel_query<2>(row, q, lane, mw); break;
            case 1: sel_query<4>(row, q, lane, mw); break;
            case 2: sel_query<6>(row, q, lane, mw); break;
            default: sel_query<8>(row, q, lane, mw); break;
        }
    }
    __syncthreads();
}
typedef __attribute__((address_space(1))) unsigned gu32;
#define XB_TMO      128
#define XB_XCNT(j)  (256  + 64 * (j))
#define XB_XSUB(j)  (1280 + 64 * (j))
#define XB_XGEN(j)  (2304 + 64 * (j))
#define XB_TOP      3328
#define XB_TOPGEN   3392
#define XCD_BAR_WORDS 3456
#define XB_SPIN_CAP (1u << 18)

__device__ __forceinline__ unsigned xb_ld(unsigned* p)              { return __hip_atomic_load(p, __ATOMIC_RELAXED, __HIP_MEMORY_SCOPE_AGENT); }
__device__ __forceinline__ unsigned xb_add(unsigned* p, unsigned v) { return __hip_atomic_fetch_add(p, v, __ATOMIC_RELAXED, __HIP_MEMORY_SCOPE_AGENT); }
__device__ __forceinline__ unsigned xb_xcc_id() { return (unsigned)__builtin_amdgcn_s_getreg((3 << 11) | 20) & 0xFu; }
#define XB_SPIN(cond, bar) do { unsigned _sp = 0; while (cond) { __builtin_amdgcn_s_sleep(1); \
    if ((++_sp & 255u) == 0u) { if (xb_ld(&(bar)[XB_TMO])) break; if (_sp > XB_SPIN_CAP) { atomicAdd(&(bar)[XB_TMO], 1u); break; } } } } while (0)

struct XcdBarrier {
    unsigned* bar; unsigned x;
    volatile LAS unsigned* st;
};

__device__ __forceinline__ XcdBarrier xcd_barrier_post(unsigned* bar, volatile LAS unsigned* st) {
    XcdBarrier b; b.bar = bar; b.x = xb_xcc_id(); b.st = st;
    if (threadIdx.x == 0) (void)xb_add(&bar[XB_XCNT(b.x)], 1u);
    return b;
}
__device__ __forceinline__ void xcd_barrier_complete(unsigned* bar, unsigned x, unsigned& nloc, unsigned& nx) {
    const unsigned G = gridDim.x * gridDim.y * gridDim.z;
    unsigned sum, cnt, mine, sp = 0u;
    for (;;) {
        sum = 0u; cnt = 0u; mine = 0u;
#pragma unroll
        for (unsigned j = 0; j < 16; ++j) { const unsigned c = xb_ld(&bar[XB_XCNT(j)]); sum += c; cnt += (c > 0u) ? 1u : 0u; mine = (j == x) ? c : mine; }
        if (sum == G) break;
        __builtin_amdgcn_s_sleep(1);
        if ((++sp & 255u) == 0u) { if (xb_ld(&bar[XB_TMO])) break; if (sp > XB_SPIN_CAP) { atomicAdd(&bar[XB_TMO], 1u); break; } }
    }
    nloc = mine > 0u ? mine : 1u; nx = cnt > 0u ? cnt : 1u;
}

__device__ __forceinline__ void xcd_barrier(const XcdBarrier& b) {
    asm volatile("s_waitcnt vmcnt(0)" ::: "memory");
    __syncthreads();
    if (threadIdx.x == 0) {
        unsigned* bar = b.bar;
        __builtin_amdgcn_s_waitcnt(0);
        unsigned nloc = b.st[0], nx = b.st[1];
        if (nloc == 0u) { xcd_barrier_complete(bar, b.x, nloc, nx); b.st[0] = nloc; b.st[1] = nx; }
        const unsigned old = xb_add(&bar[XB_XSUB(b.x)], 1u);
        const unsigned gen = old / nloc;
        if (old + 1u == (gen + 1u) * nloc) {
            __builtin_amdgcn_fence(__ATOMIC_RELEASE, "agent");
            asm volatile("s_waitcnt vmcnt(0)" ::: "memory");
            const unsigned og = xb_add(&bar[XB_TOP], 1u);
            const unsigned tg = og / nx;
            if (og + 1u == (tg + 1u) * nx) xb_add(&bar[XB_TOPGEN], 1u);
            else XB_SPIN(xb_ld(&bar[XB_TOPGEN]) == tg, bar);
            __builtin_amdgcn_fence(__ATOMIC_ACQUIRE, "agent");
            xb_add(&bar[XB_XGEN(b.x)], 1u);
            asm volatile("s_waitcnt vmcnt(0)" ::: "memory");
        } else {
            XB_SPIN(xb_ld(&bar[XB_XGEN(b.x)]) == gen, bar);
            __builtin_amdgcn_fence(__ATOMIC_ACQUIRE, "agent");
            asm volatile("s_waitcnt vmcnt(0)" ::: "memory");
        }
    }
    __syncthreads();
}

namespace cg = cooperative_groups;
#ifndef MK_LAUNCHES
#define MK_LAUNCHES 1
#endif
#ifndef MK_COOP
#define MK_COOP 0
#endif
constexpr int N_PHASES = 6;
__global__ void __launch_bounds__(512, 2) mk_fwd(Params P_arg, int ph_lo, int ph_hi) {
#define P (*(const Params*)__builtin_amdgcn_kernarg_segment_ptr())
    (void)P_arg;
    extern __shared__ __attribute__((aligned(16))) unsigned char lds_raw[];
    LAS unsigned char* lds = (LAS unsigned char*)lds_raw;
#if MK_COOP
    cg::grid_group grid = cg::this_grid();
#endif
    if (threadIdx.x < 2) *(volatile LAS unsigned*)(lds + LDS_MISC + 32 + 4 * threadIdx.x) = 0u;
    __syncthreads();
#if MK_COOP
    XcdBarrier xbar; xbar.bar = P.ctl + CTL_BAR; xbar.x = 0; xbar.st = (volatile LAS unsigned*)(lds + LDS_MISC + 32);
#else
    XcdBarrier xbar = xcd_barrier_post(P.ctl + CTL_BAR, (volatile LAS unsigned*)(lds + LDS_MISC + 32));
#endif
    const int wave = threadIdx.x >> 6;
#define IN(k) (ph_lo <= (k) && (k) < ph_hi)
#if MK_COOP
#define SEAM(k) do { if (IN(k) && IN((k) + 1)) { if ((k) == 0) { grid.sync(); xbar = xcd_barrier_post(P.ctl + CTL_BAR, (volatile LAS unsigned*)(lds + LDS_MISC + 32)); } else { xcd_barrier(xbar); } } } while (0)
#else
#define SEAM(k) do { if (IN(k) && IN((k) + 1)) xcd_barrier(xbar); } while (0)
#endif
    if (IN(0)) p0_prologue(P, lds);
    SEAM(0);
    if (IN(1)) p1_norm(P);
    SEAM(1);
    if (IN(2)) { pg8::Gemm g{P.H, P.win_t, MT, NPAD, 1024}; pg8::StaticOrder S; S.init(MT, NPAD, gridDim.x, (int)blockIdx.x); EpiProj E{P};
        pg8::gemm_phase<EpiProj, pg8::StaticOrder, true, true>(lds, g, S, E); }
    SEAM(2);
    if (IN(3)) {
        for (int pr = blockIdx.x * 8 + wave; pr < 1024; pr += gridDim.x * 8) ssm_pair(P, lds + wave * (32 * SROW), pr >> 5, pr & 31);
        for (;;) {
            __syncthreads();
            if (threadIdx.x == 0) *(volatile LAS unsigned*)(lds + LDS_MISC) = atomicAdd(P.ctl, 1u);
            __syncthreads();
            const unsigned ord = *(volatile LAS unsigned*)(lds + LDS_MISC);
            if (ord >= 4096u) break;
            idx_unit(P, lds, (int)((ord & 31u) * 128u + (127u - (ord >> 5))));
        }
    }
    SEAM(3);
    if (IN(4)) {
        { const attn_body::AttnTensors AT{P.Q, P.K, P.V, P.H + 512, P.ZA, P.mask}; const attn_body::StaticOrder S((int)gridDim.x, (int)blockIdx.x);
          attn_body::attn_phase<attn_body::StaticOrder>((char*)lds_raw, AT, P.rel_bias, S); }
        __syncthreads();
        pg8::Gemm g{P.ZG, P.wglu_t, MT, 512, 512}; pg8::StaticOrder S; S.init(MT, 512, gridDim.x, (int)blockIdx.x); EpiGlu E{P};
        pg8::gemm_phase<EpiGlu, pg8::StaticOrder, true, true>(lds, g, S, E);
    }
    SEAM(4);
    if (IN(5)) { pg8::Gemm g{P.H, P.wout_t, MT, 1024, 1024}; pg8::StaticOrder S; S.init(MT, 1024, gridDim.x, (int)blockIdx.x); EpiOut E{P};
        pg8::gemm_phase<EpiOut, pg8::StaticOrder, true, true>(lds, g, S, E); }
#undef IN
#undef SEAM
#undef P
}

extern "C" void kernel_launch(void* const* d_in, const int* in_sizes, int n_in, void* d_out, int out_size, void* d_ws, size_t ws_size, hipStream_t stream) {
    static int grid_blocks = 0;
    if (!grid_blocks) {
        if (n_in != 20 || in_sizes[0] != MT * DM || out_size != MT * DM || ws_size < WS_END) { fprintf(stderr, "kernel_launch: unexpected shapes (n_in %d, in0 %d, out %d, ws %zu)\n", n_in, n_in > 0 ? in_sizes[0] : -1, out_size, ws_size); grid_blocks = -1; return; }
        if (hipFuncSetAttribute((const void*)mk_fwd, hipFuncAttributeMaxDynamicSharedMemorySize, LDS_BYTES) != hipSuccess) { fprintf(stderr, "kernel_launch: hipFuncSetAttribute failed\n"); grid_blocks = -1; return; }
        int dev = 0, cus = 0, per_cu = 0;
        (void)hipGetDevice(&dev); (void)hipDeviceGetAttribute(&cus, hipDeviceAttributeMultiprocessorCount, dev);
        (void)hipOccupancyMaxActiveBlocksPerMultiprocessor(&per_cu, (const void*)mk_fwd, 512, LDS_BYTES);
        if (per_cu < 1) { fprintf(stderr, "kernel_launch: occupancy query says %d blocks per CU\n", per_cu); grid_blocks = -1; return; }
        grid_blocks = cus;
    }
    if (grid_blocks < 0) return;
    Params P{};
    const float* const* in = (const float* const*)d_in;
    P.x = in[0]; P.c = in[1]; P.rel_bias = in[2]; P.norm_g = in[3]; P.w_ada = in[4]; P.b_ada = in[5]; P.w_in = in[6]; P.q_gain = in[7]; P.k_gain = in[8]; P.a_re = in[9]; P.a_im = in[10];
    P.log_dt = in[11]; P.b_re = in[12]; P.b_im = in[13]; P.c_re = in[14]; P.c_im = in[15]; P.d_skip = in[16]; P.w_glu = in[17]; P.b_glu = in[18]; P.w_out = in[19];
    unsigned char* ws = (unsigned char*)d_ws;
    P.out = (float*)d_out; P.mod = (float*)(ws + WS_MOD); P.win_t = (u16*)(ws + WS_WIN); P.wout_t = (u16*)(ws + WS_WOUT); P.wglu_t = (u16*)(ws + WS_WGLU);
    P.LB = (f32x2*)(ws + WS_LB); P.BB = (f32x2*)(ws + WS_BB); P.H = (u16*)(ws + WS_H); P.U = (u16*)(ws + WS_U); P.ZS = (u16*)(ws + WS_ZS); P.Q = (u16*)(ws + WS_Q); P.K = (u16*)(ws + WS_K);
    P.V = (u16*)(ws + WS_V); P.ZA = (u16*)(ws + WS_ZA); P.QI = (u16*)(ws + WS_QI); P.KI = (u16*)(ws + WS_KI); P.WI = (float*)(ws + WS_WI); P.ZG = (u16*)(ws + WS_ZG); P.mask = (unsigned*)(ws + WS_MASK);
    P.BBh = (u16*)(ws + WS_BBH); P.CCh = (u16*)(ws + WS_CCH); P.DT = (float*)(ws + WS_DT); P.ctl = (unsigned*)ws;
#if MK_LAUNCHES == 1
    int lo = 0, hi = N_PHASES;
    void* args[] = {&P, &lo, &hi};
#if MK_COOP
    const hipError_t e = hipLaunchCooperativeKernel((const void*)mk_fwd, dim3(grid_blocks), dim3(512), args, LDS_BYTES, stream);
    if (e != hipSuccess) fprintf(stderr, "kernel_launch: cooperative launch failed: %s (grid %d)\n", hipGetErrorString(e), grid_blocks);
#else
    (void)args;
    if (hipMemsetAsync(d_ws, 0, (size_t)CTL_WORDS * 4, stream) != hipSuccess) { fprintf(stderr, "kernel_launch: hipMemsetAsync failed\n"); return; }
    hipLaunchKernelGGL(mk_fwd, dim3(grid_blocks), dim3(512), LDS_BYTES, stream, P, lo, hi);
#endif
#else
    for (int ph = 0; ph < N_PHASES; ++ph) hipLaunchKernelGGL(mk_fwd, dim3(grid_blocks), dim3(512), LDS_BYTES, stream, P, ph, ph + 1);
#endif
}
```
